# Optimizing an MI355X kernel written in HIP

```python
import jax, jax.numpy as jnp
from jax import lax
import numpy as np

D_MODEL = 1024
BATCH = 32
SEQ = 2048
DEPTH = 4

CHUNK = 128
GMLP_WIDTH = D_MODEL // 2
GMLP_HEADS = 4
GMLP_HEAD_DIM = GMLP_WIDTH // GMLP_HEADS
RET_WIDTH = D_MODEL // 2
RET_HEADS = 4
RET_HEAD_DIM = RET_WIDTH // RET_HEADS
MIX_WIDTH = GMLP_WIDTH + RET_WIDTH
IN_COLS = 2 * GMLP_WIDTH + 4 * RET_WIDTH
ROPE_BASE = 10000.0
N_EXPERTS = 32
TOP_K = 4
EXPERT_FF = D_MODEL
SWIGLU_ALPHA = 1.702
SWIGLU_LIMIT = 7.0
BLOCK = 128
EPS = 1e-5
N_MOD = 6

kernel_name = "hybrid_gmlp_retention_moe_adaln"

F32 = jnp.float32


def rms_norm(x, g):
    xf = x.astype(F32)
    y = xf * lax.rsqrt(jnp.mean(xf * xf, axis=-1, keepdims=True) + EPS)
    return (y * g.astype(F32)).astype(x.dtype)


def layer_norm(x, g, b):
    xf = x.astype(F32)
    xc = xf - jnp.mean(xf, axis=-1, keepdims=True)
    var = jnp.mean(xc * xc, axis=-1, keepdims=True)
    return (xc * lax.rsqrt(var + EPS) * g.astype(F32) + b.astype(F32)).astype(x.dtype)


def rotary(x):
    seq, d = x.shape[1], x.shape[-1]
    half = d // 2
    inv_freq = ROPE_BASE ** (-jnp.arange(half, dtype=F32) / half)
    ang = jnp.arange(seq, dtype=F32)[:, None] * inv_freq[None, :]
    cos = jnp.cos(ang)[None, :, None, :]
    sin = jnp.sin(ang)[None, :, None, :]
    x1, x2 = x[..., :half], x[..., half:]
    return jnp.concatenate([x1 * cos - x2 * sin, x1 * sin + x2 * cos], axis=-1)


def chunked_spatial_gating(u, v, w_s, b_s, ln_g, ln_b):
    bsz, seq, _ = v.shape
    nc = seq // CHUNK
    v = layer_norm(v, ln_g, ln_b)
    vh = v.reshape(bsz, nc, CHUNK, GMLP_HEADS, GMLP_HEAD_DIM)
    causal = jnp.tril(jnp.ones((CHUNK, CHUNK), dtype=bool))
    w = jnp.where(causal[None], w_s, jnp.zeros_like(w_s))
    mixed = jnp.einsum('hts,bnshd->bnthd', w, vh) + b_s.T[None, None, :, :, None]
    return u * mixed.reshape(bsz, seq, GMLP_WIDTH)


def chunkwise_retention(q, k, v):
    bsz, seq, n_heads, d = q.shape
    nc = seq // CHUNK
    gamma = 1.0 - jnp.exp2(-5.0 - jnp.arange(n_heads, dtype=F32))
    log_g = jnp.log(gamma)
    idx = jnp.arange(CHUNK, dtype=F32)
    diff = idx[:, None] - idx[None, :]
    intra_decay = jnp.where(diff[None] >= 0,
                            jnp.exp(log_g[:, None, None] * jnp.maximum(diff, 0.0)[None]),
                            0.0)
    qc = q.reshape(bsz, nc, CHUNK, n_heads, d)
    kc = k.reshape(bsz, nc, CHUNK, n_heads, d)
    vc = v.reshape(bsz, nc, CHUNK, n_heads, d)
    scores = jnp.einsum('bnthk,bnshk->bnhts', qc, kc) * intra_decay[None, None]
    intra = jnp.einsum('bnhts,bnshv->bnthv', scores, vc)
    k_decay = jnp.exp(log_g[:, None] * (CHUNK - 1.0 - idx)[None, :])
    chunk_kv = jnp.einsum('bnshk,hs,bnshv->nbhkv', kc, k_decay, vc)
    chunk_decay = jnp.exp(log_g * CHUNK)

    def step(state, kv):
        return state * chunk_decay[None, :, None, None] + kv, state

    _, prev_state = lax.scan(step, jnp.zeros((bsz, n_heads, d, d), F32), chunk_kv)
    q_decay = jnp.exp(log_g[:, None] * (idx + 1.0)[None, :])
    cross = jnp.einsum('bnthk,nbhkv,ht->bnthv', qc, prev_state, q_decay)
    return (intra + cross).reshape(bsz, seq, n_heads, d)


def hybrid_mixer(h, w_in, ln_g, ln_b, w_s, b_s, ret_norm_g, w_out):
    bsz, seq, _ = h.shape
    proj = jnp.dot(h, w_in)
    gw, rw = GMLP_WIDTH, RET_WIDTH
    u, v, q, k, vr, g = jnp.split(
        proj, [gw, 2 * gw, 2 * gw + rw, 2 * gw + 2 * rw, 2 * gw + 3 * rw], axis=-1)
    out_a = chunked_spatial_gating(jax.nn.gelu(u), jax.nn.gelu(v), w_s, b_s, ln_g, ln_b)
    shp = (bsz, seq, RET_HEADS, RET_HEAD_DIM)
    qf = rotary(q.astype(F32).reshape(shp))
    kf = rotary(k.astype(F32).reshape(shp)) * (RET_HEAD_DIM ** -0.5)
    ret = chunkwise_retention(qf, kf, vr.astype(F32).reshape(shp))
    ret = ret * lax.rsqrt(jnp.mean(ret * ret, axis=-1, keepdims=True) + EPS)
    ret = ret * ret_norm_g.astype(F32).reshape(RET_HEADS, RET_HEAD_DIM)
    out_b = ret.reshape(bsz, seq, rw).astype(h.dtype) * jax.nn.silu(g)
    return jnp.dot(jnp.concatenate([out_a, out_b], axis=-1), w_out)


def clamped_swiglu(a):
    a_glu, a_lin = jnp.split(a, 2, axis=-1)
    a_glu = jnp.minimum(a_glu, SWIGLU_LIMIT)
    a_lin = jnp.clip(a_lin, -SWIGLU_LIMIT, SWIGLU_LIMIT)
    return a_glu * jax.nn.sigmoid(SWIGLU_ALPHA * a_glu) * (a_lin + 1.0)


def moe_ffn(h, w_router, b_router, w1, b1, w2, b2):
    bsz, seq, d = h.shape
    t = h.reshape(-1, d)
    n_tok = t.shape[0]
    n_assign = n_tok * TOP_K
    logits = jnp.dot(t, w_router).astype(F32) + b_router.astype(F32)
    top_logits, top_idx = lax.top_k(logits, TOP_K)
    top_w = jax.nn.softmax(top_logits, axis=-1)
    flat_e = top_idx.reshape(-1)
    flat_tok = jnp.arange(n_assign, dtype=jnp.int32) // TOP_K
    flat_w = top_w.reshape(-1)
    order = jnp.argsort(flat_e, stable=True)
    se, stok, sw = flat_e[order], flat_tok[order], flat_w[order]
    counts = jnp.bincount(flat_e, length=N_EXPERTS)
    group_start = jnp.cumsum(counts) - counts
    padded = ((counts + BLOCK - 1) // BLOCK) * BLOCK
    padded_end = jnp.cumsum(padded)
    padded_start = padded_end - padded
    slot = padded_start[se] + (jnp.arange(n_assign, dtype=jnp.int32) - group_start[se])
    n_slots = n_assign + N_EXPERTS * BLOCK
    n_blocks = n_slots // BLOCK
    slot_tok = jnp.zeros((n_slots,), jnp.int32).at[slot].set(stok)
    slot_w = jnp.zeros((n_slots,), F32).at[slot].set(sw)
    block_expert = jnp.minimum(
        jnp.searchsorted(padded_end, jnp.arange(n_blocks) * BLOCK, side='right'), N_EXPERTS - 1)

    def run_block(args):
        tok, e = args
        a = jnp.dot(t[tok], w1[e]) + b1[e]
        return jnp.dot(clamped_swiglu(a), w2[e]) + b2[e]

    y = lax.map(run_block, (slot_tok.reshape(n_blocks, BLOCK), block_expert))
    y = y.reshape(n_slots, d) * slot_w[:, None].astype(y.dtype)
    out = jnp.zeros_like(t).at[slot_tok].add(y)
    return out.reshape(bsz, seq, d)


def setup_inputs(seed: int = 0) -> dict:
    key = jax.random.key(seed)
    ks = jax.random.split(key, 20)
    d, f = D_MODEL, EXPERT_FF
    nrm = lambda k, shp, s: jax.random.normal(k, shp, F32) * s
    return {
        "x": nrm(ks[0], (BATCH, SEQ, d), 1.0),
        "c": nrm(ks[1], (BATCH, d), 1.0),
        "w_ada": nrm(ks[2], (DEPTH, d, N_MOD * d), 0.5 * d ** -0.5),
        "b_ada": nrm(ks[3], (DEPTH, N_MOD * d), 0.01),
        "g_mix": 1.0 + nrm(ks[4], (DEPTH, d), 0.01),
        "w_in": nrm(ks[5], (DEPTH, d, IN_COLS), d ** -0.5),
        "gmlp_ln_g": 1.0 + nrm(ks[6], (DEPTH, GMLP_WIDTH), 0.01),
        "gmlp_ln_b": nrm(ks[7], (DEPTH, GMLP_WIDTH), 0.01),
        "w_spatial": nrm(ks[8], (DEPTH, GMLP_HEADS, CHUNK, CHUNK), CHUNK ** -0.5),
        "b_spatial": 1.0 + nrm(ks[9], (DEPTH, GMLP_HEADS, CHUNK), 0.01),
        "ret_norm_g": 1.0 + nrm(ks[10], (DEPTH, RET_WIDTH), 0.01),
        "w_out": nrm(ks[11], (DEPTH, MIX_WIDTH, d), MIX_WIDTH ** -0.5),
        "g_ffn": 1.0 + nrm(ks[12], (DEPTH, d), 0.01),
        "w_router": nrm(ks[13], (DEPTH, d, N_EXPERTS), d ** -0.5),
        "b_router": nrm(ks[14], (DEPTH, N_EXPERTS), 0.01),
        "w1": nrm(ks[15], (DEPTH, N_EXPERTS, d, 2 * f), d ** -0.5),
        "b1": nrm(ks[16], (DEPTH, N_EXPERTS, 2 * f), 0.01),
        "w2": nrm(ks[17], (DEPTH, N_EXPERTS, f, d), f ** -0.5),
        "b2": nrm(ks[18], (DEPTH, N_EXPERTS, d), 0.01),
        "g_final": 1.0 + nrm(ks[19], (d,), 0.01),
    }


def reference(x, c, w_ada, b_ada, g_mix, w_in, gmlp_ln_g, gmlp_ln_b, w_spatial, b_spatial,
              ret_norm_g, w_out, g_ffn, w_router, b_router, w1, b1, w2, b2, g_final):
    c_act = jax.nn.silu(c)
    for l in range(DEPTH):
        mod = jnp.dot(c_act, w_ada[l]) + b_ada[l]
        sh_m, sc_m, gt_m, sh_f, sc_f, gt_f = [m[:, None, :] for m in jnp.split(mod, N_MOD, axis=-1)]
        h = rms_norm(x, g_mix[l]) * (1.0 + sc_m) + sh_m
        x = x + gt_m * hybrid_mixer(h, w_in[l], gmlp_ln_g[l], gmlp_ln_b[l], w_spatial[l],
                                    b_spatial[l], ret_norm_g[l], w_out[l])
        h = rms_norm(x, g_ffn[l]) * (1.0 + sc_f) + sh_f
        x = x + gt_f * moe_ffn(h, w_router[l], b_router[l], w1[l], b1[l], w2[l], b2[l])
    return rms_norm(x, g_final)
```

```cpp
#include <hip/hip_runtime.h>
#include <cstdio>
#include <cstdint>
#include <cstddef>

#ifndef MK_LAUNCH_PER_PHASE
#define MK_LAUNCH_PER_PHASE 0
#endif

namespace {
#define LAS __attribute__((address_space(3)))
#define GAS __attribute__((address_space(1)))
#define CAS __attribute__((address_space(4)))
#define DI __device__ __forceinline__
typedef unsigned short bf16_t;
typedef short bf16x8 __attribute__((ext_vector_type(8)));
typedef short s16x4 __attribute__((ext_vector_type(4)));
typedef float f32x4 __attribute__((ext_vector_type(4)));
typedef float f32x2 __attribute__((ext_vector_type(2)));
typedef unsigned u32x4 __attribute__((ext_vector_type(4)));
typedef unsigned u32x2 __attribute__((ext_vector_type(2)));
typedef int i32x8 __attribute__((ext_vector_type(8)));
typedef int i32x4 __attribute__((ext_vector_type(4)));

constexpr int D = 1024, BATCH = 32, SEQ = 2048, DEPTH = 4, T = BATCH * SEQ;
constexpr int CHUNK = 128, NCHUNK = SEQ / CHUNK, INC = 3072, HD = 128;
constexpr int NE = 32, TOPK = 4, FF = 1024, NMOD = 6;
constexpr int NSLOT = T * TOPK + NE * 256;
constexpr int ECAP = T;
constexpr float EPS = 1e-5f;
constexpr int NWAVES = 8, NTHR = 512;

constexpr size_t MiB = 1u << 20;
constexpr size_t WS_CTL = 0, CTL_BYTES = 64 * 1024;
constexpr size_t WS_MOD = 1 * MiB;
constexpr size_t WS_ROPE = 4 * MiB;
constexpr size_t WS_WST = 5 * MiB;
constexpr size_t WS_WRT = 3024 * MiB;
constexpr int WRI_ROWB = 2064, WRI_BYTES = 2 * 32 * WRI_ROWB;
constexpr size_t WS_TOKINFO = 6 * MiB;
constexpr size_t WS_TOKW = 7 * MiB;
constexpr size_t WS_SLOTTOK = 8 * MiB;
constexpr size_t WS_WIN = 16 * MiB;
constexpr size_t WS_WOUT = 40 * MiB;
constexpr size_t WS_W1 = 48 * MiB;
constexpr size_t WS_W2 = 560 * MiB;
constexpr size_t WS_H = 816 * MiB;
constexpr size_t WS_PROJ = 944 * MiB;
constexpr size_t WS_MIX = 1328 * MiB;
constexpr size_t WS_XA = 1456 * MiB;
constexpr size_t WS_XB = 1712 * MiB;
constexpr size_t WS_ACT = 1968 * MiB;
constexpr size_t WS_Y = 2496 * MiB;
constexpr size_t WS_END = 3025 * MiB;
static_assert(WS_WRT + 4 * (size_t)WRI_BYTES <= WS_END, "router image");
static_assert((size_t)NSLOT * 1024 * 2 <= 528 * MiB, "slot buffers");
constexpr int CW_BAR = 1024;
constexpr int CW_CNT = 8192;
static_assert((CW_BAR + 3456) * 4 <= 32768 && (CW_CNT + DEPTH * 64) * 4 <= (int)CTL_BYTES, "control words inside the per-call memset");

constexpr int RING_BYTES = 131072;
constexpr int L_TBL = RING_BYTES;
constexpr int L_MISC = L_TBL + 1024;
constexpr int L_TPRE = L_MISC + 64;
constexpr int L_CNT = L_MISC + 256;
constexpr int L_BASE = L_MISC + 384;
constexpr int L_LCNT = L_MISC + 512;
constexpr int L_RT2E = L_MISC + 1024;
constexpr int L_TINFO = L_MISC + 3200;
constexpr int L_TW = L_TINFO + 4096;
constexpr int L_GM = L_TW + 4096;
constexpr int L_SV = L_GM + 4096;
constexpr int LDS_BYTES = L_SV + 4096 + 512;
static_assert(WRI_BYTES <= L_MISC, "N2's router image must end below the control words");
static_assert(LDS_BYTES <= 160 * 1024 && L_TINFO + 16896 <= LDS_BYTES && 7 * 16896 <= RING_BYTES, "LDS budget");

DI unsigned f2bf(float f) { unsigned u = __builtin_bit_cast(unsigned, f); return (u + 0x7fffu + ((u >> 16) & 1u)) >> 16; }
DI unsigned pk2(float lo, float hi) { unsigned r; asm volatile("v_cvt_pk_bf16_f32 %0, %1, %2" : "=v"(r) : "v"(lo), "v"(hi)); return r; }
DI unsigned pk4_fp8(float a, float b, float c, float d) { int r = 0; r = __builtin_amdgcn_cvt_pk_fp8_f32(a, b, r, false); r = __builtin_amdgcn_cvt_pk_fp8_f32(c, d, r, true); return (unsigned)r; }
DI f32x4 unpk4_fp8(unsigned w) { const f32x2 lo = __builtin_amdgcn_cvt_pk_f32_fp8((int)w, false), hi = __builtin_amdgcn_cvt_pk_f32_fp8((int)w, true); return (f32x4){lo.x, lo.y, hi.x, hi.y}; }
DI float clamp8(float x) { return __builtin_amdgcn_fmed3f(x, -448.0f, 448.0f); }
DI float bflo(unsigned w) { return __builtin_bit_cast(float, w << 16); }
DI float bfhi(unsigned w) { return __builtin_bit_cast(float, w & 0xffff0000u); }
DI float wave_sum(float v) {
#pragma unroll
    for (int o = 1; o < 64; o <<= 1) v += __shfl_xor(v, o);
    return v;
}
DI float gelu_tanh(float x) {
    const float u = x * (1.0f + 0.044715f * x * x) * (-1.5957691216057308f * 1.4426950408889634f);
    return x * __builtin_amdgcn_rcpf(1.0f + __builtin_amdgcn_exp2f(u));
}
DI float silu_f(float x) { return x * __builtin_amdgcn_rcpf(1.0f + __builtin_amdgcn_exp2f(x * -1.4426950408889634f)); }

#define XB_TMO      128
#define XB_XCNT(j)  (256  + 64 * (j))
#define XB_XSUB(j)  (1280 + 64 * (j))
#define XB_XGEN(j)  (2304 + 64 * (j))
#define XB_TOP      3328
#define XB_TOPGEN   3392
#define XCD_BAR_WORDS 3456
#define XB_SPIN_CAP (1u << 22)

DI unsigned xb_ld(GAS unsigned* p)              { return __hip_atomic_load(p, __ATOMIC_RELAXED, __HIP_MEMORY_SCOPE_AGENT); }
DI unsigned xb_add(GAS unsigned* p, unsigned v) { return __hip_atomic_fetch_add(p, v, __ATOMIC_RELAXED, __HIP_MEMORY_SCOPE_AGENT); }
DI unsigned xb_xcc_id() { return (unsigned)__builtin_amdgcn_s_getreg((3 << 11) | 20) & 0xFu; }
#define XB_SPIN(cond, bar) do { unsigned _sp = 0; while (cond) { __builtin_amdgcn_s_sleep(1); \
    if ((++_sp & 255u) == 0u) { if (xb_ld(&(bar)[XB_TMO])) break; if (_sp > XB_SPIN_CAP) { (void)xb_add(&(bar)[XB_TMO], 1u); break; } } } } while (0)

struct XcdBarrier { GAS unsigned* bar; unsigned x; volatile LAS unsigned* st; };

DI XcdBarrier xcd_barrier_post(GAS unsigned* bar, volatile LAS unsigned* st) {
    XcdBarrier b; b.bar = bar; b.x = xb_xcc_id(); b.st = st;
    if (threadIdx.x == 0) (void)xb_add(&bar[XB_XCNT(b.x)], 1u);
    return b;
}
DI void xcd_barrier_complete(GAS unsigned* bar, unsigned x, unsigned& nloc, unsigned& nx) {
    const unsigned G = gridDim.x * gridDim.y * gridDim.z;
    unsigned sum, cnt, mine, sp = 0u;
    for (;;) {
        sum = 0u; cnt = 0u; mine = 0u;
#pragma unroll
        for (unsigned j = 0; j < 16; ++j) { const unsigned c = xb_ld(&bar[XB_XCNT(j)]); sum += c; cnt += (c > 0u) ? 1u : 0u; mine = (j == x) ? c : mine; }
        if (sum == G) break;
        __builtin_amdgcn_s_sleep(1);
        if ((++sp & 255u) == 0u) { if (xb_ld(&bar[XB_TMO])) break; if (sp > XB_SPIN_CAP) { (void)xb_add(&bar[XB_TMO], 1u); break; } }
    }
    nloc = mine > 0u ? mine : 1u; nx = cnt > 0u ? cnt : 1u;
}
DI void xcd_barrier(const XcdBarrier& b) {
    asm volatile("s_waitcnt vmcnt(0)" ::: "memory");
    __syncthreads();
    if (threadIdx.x == 0) {
        GAS unsigned* bar = b.bar;
        __builtin_amdgcn_s_waitcnt(0);
        unsigned nloc = b.st[0], nx = b.st[1];
        if (nloc == 0u) { xcd_barrier_complete(bar, b.x, nloc, nx); b.st[0] = nloc; b.st[1] = nx; }
        const unsigned old = xb_add(&bar[XB_XSUB(b.x)], 1u);
        const unsigned gen = old / nloc;
        if (old + 1u == (gen + 1u) * nloc) {
            __builtin_amdgcn_fence(__ATOMIC_RELEASE, "agent");
            asm volatile("s_waitcnt vmcnt(0)" ::: "memory");
            const unsigned og = xb_add(&bar[XB_TOP], 1u);
            const unsigned tg = og / nx;
            if (og + 1u == (tg + 1u) * nx) xb_add(&bar[XB_TOPGEN], 1u);
            else XB_SPIN(xb_ld(&bar[XB_TOPGEN]) == tg, bar);
            __builtin_amdgcn_fence(__ATOMIC_ACQUIRE, "agent");
            xb_add(&bar[XB_XGEN(b.x)], 1u);
            asm volatile("s_waitcnt vmcnt(0)" ::: "memory");
        } else {
            XB_SPIN(xb_ld(&bar[XB_XGEN(b.x)]) == gen, bar);
            __builtin_amdgcn_fence(__ATOMIC_ACQUIRE, "agent");
            asm volatile("s_waitcnt vmcnt(0)" ::: "memory");
        }
    }
    __syncthreads();
}

struct Args { const float* in[20]; float* out; unsigned char* ws; int ph_lo, ph_hi; };
static_assert(offsetof(Args, in) == 0, "Frame::in reads the kernarg segment from offset 0");
enum { I_X = 0, I_C, I_WADA, I_BADA, I_GMIX, I_WIN, I_LNG, I_LNB, I_WSP, I_BSP, I_RNG, I_WOUT, I_GFFN, I_WR, I_BR, I_W1, I_B1, I_W2, I_B2, I_GFIN };

template <class P> DI P launder_s(P p) { const unsigned long long v = (unsigned long long)p; unsigned lo = __builtin_amdgcn_readfirstlane((unsigned)v), hi = __builtin_amdgcn_readfirstlane((unsigned)(v >> 32));
    asm volatile("" : "+s"(lo), "+s"(hi)); return (P)(((unsigned long long)hi << 32) | lo); }
struct Frame {
    LAS unsigned char* lds;
    GAS unsigned char* ws;
    const GAS float* const CAS* in;
    GAS float* out;
    int tid, lane, wave, G, c;
};

constexpr int BM = 256, BK = 64, HALF = 128, HTB = HALF * BK * 2, GK = 1024;
DI int lds_byte(int r, int c) { const int st = (r >> 4) * 2 + (c >> 5), rr = r & 15, cc = c & 31, ob = rr * 64 + cc * 2; return st * 1024 + (ob ^ (((ob >> 9) & 1) << 5)); }
DI void stage_rc(int b, int& R, int& C) { const int st = b / 1024, sb = b % 1024, swz = sb ^ (((sb >> 9) & 1) << 5); R = (st >> 1) * 16 + swz / 64; C = (st & 1) * 32 + (swz % 64) / 2; }
DI int perm32(int rho) { const int n = rho >> 4, i = rho & 15; return 8 * (i >> 2) + 4 * n + (i & 3); }

struct GUnit { int row0, pn, e, aux; };

template <class Epi, class Sched>
DI void gemm_phase(LAS unsigned char* lds, Sched& S, const Epi& E) {
    int tid_ = threadIdx.x; asm volatile("" : "+v"(tid_));
    const int tid = tid_, wid = __builtin_amdgcn_readfirstlane(tid >> 6), lane = tid & 63, wr = wid >> 2, wc = wid & 3, fr = lane & 15, fq = lane >> 4;
    constexpr bool GATHER = Sched::GATHER, FP8 = Sched::FP8;
    constexpr int ROWB = FP8 ? GK : GK * 2, nt = ROWB / 128;
    unsigned voffA, voffB; int rowA, colA2;
    { int R, C; stage_rc(tid * 16, R, C); const int Rb = Epi::PERM ? ((R & ~31) + perm32(R & 31)) : R;
        voffA = (unsigned)(R * ROWB + C * 2); voffB = (unsigned)(Rb * ROWB + C * 2); rowA = R; colA2 = C * 2; }
    constexpr size_t rstep = (size_t)64 * ROWB;
    constexpr size_t kstep = (size_t)(BK * 2);
    constexpr size_t hstep = (size_t)HALF * ROWB;
    const unsigned ldsw = (unsigned)wid * 1024u;
    const int aoff = lds_byte(wr * 64 + fr, fq * 8), boff = lds_byte(wc * 32 + fr, fq * 8);
    LAS unsigned* TBL = (LAS unsigned*)(lds + L_TBL);
    constexpr unsigned TB2 = (unsigned)(L_GM + 2048 - L_TBL) / 4u; unsigned tn = 0u;
#define PG8_SA(b, h) (((b) * 2 + (h)) * HTB)
#define PG8_SB(b, h) ((4 + (b) * 2 + (h)) * HTB)
#define PG8_STAGE(bufoff, gbase, voff) do { _Pragma("unroll") for (int _i = 0; _i < 2; ++_i) \
        __builtin_amdgcn_global_load_lds((const GAS unsigned*)((const GAS char*)(gbase) + _i * rstep + (voff)), (LAS unsigned*)(lds + (bufoff) + ldsw + _i * 8192), 16, 0, 0); } while (0)
#define PG8_STAGE_G(bufoff, gbase, voff2) do { _Pragma("unroll") for (int _i = 0; _i < 2; ++_i) \
        __builtin_amdgcn_global_load_lds((const GAS unsigned*)((const GAS char*)(gbase) + (voff2)[_i]), (LAS unsigned*)(lds + (bufoff) + ldsw + _i * 8192), 16, 0, 0); } while (0)
#define PG8_STAGE_A(bufoff, ubase, h, gofs) do { if constexpr (GATHER) { PG8_STAGE_G(bufoff, ubase, (gofs)[h]); } else { PG8_STAGE(bufoff, (ubase) + (h) * hstep, voffA); } } while (0)
#define PG8_LDA(dst, b, h) do { _Pragma("unroll") for (int m = 0; m < 4; ++m) _Pragma("unroll") for (int k = 0; k < 2; ++k) dst[m][k] = *(const LAS bf16x8*)(lds + PG8_SA(b, h) + aoff + m * 2048 + k * 1024); } while (0)
#define PG8_LDB(dst, b, h) do { _Pragma("unroll") for (int n = 0; n < 2; ++n) _Pragma("unroll") for (int k = 0; k < 2; ++k) dst[n][k] = *(const LAS bf16x8*)(lds + PG8_SB(b, h) + boff + n * 2048 + k * 1024); } while (0)
#define PG8_MMA(ai, bj, At, Bt) do { __builtin_amdgcn_s_setprio(1); _Pragma("unroll") for (int m = 0; m < 4; ++m) _Pragma("unroll") for (int n = 0; n < 2; ++n) { \
        if constexpr (FP8) { const i32x8 b8 = __builtin_shufflevector(__builtin_bit_cast(i32x4, Bt[n][0]), __builtin_bit_cast(i32x4, Bt[n][1]), 0, 1, 2, 3, 4, 5, 6, 7), a8 = __builtin_shufflevector(__builtin_bit_cast(i32x4, At[m][0]), __builtin_bit_cast(i32x4, At[m][1]), 0, 1, 2, 3, 4, 5, 6, 7); \
            asm volatile("v_mfma_scale_f32_16x16x128_f8f6f4 %0, %1, %2, %0, %3, %4 op_sel_hi:[0,0,0]" : "+v"(acc[ai][bj][m][n]) : "v"(b8), "v"(a8), "v"(scB), "v"(scA)); } \
        else { _Pragma("unroll") for (int k = 0; k < 2; ++k) acc[ai][bj][m][n] = __builtin_amdgcn_mfma_f32_16x16x32_bf16(Bt[n][k], At[m][k], acc[ai][bj][m][n], 0, 0, 0); } } \
        __builtin_amdgcn_s_setprio(0); } while (0)
#define PG8_WAIT_V(n) asm volatile("s_waitcnt vmcnt(" #n ")" ::: "memory")
#define PG8_WAIT_L(n) asm volatile("s_waitcnt lgkmcnt(" #n ")" ::: "memory")
#define PG8_BAR __builtin_amdgcn_s_barrier()
#define PG8_SCHED __builtin_amdgcn_sched_barrier(0)
    int scA = Sched::SCALE_A, scB = Sched::SCALE_B; asm volatile("" : "+v"(scA), "+v"(scB));
    GUnit cur, nxt, nn; bool has_nn = false;
    if (!S.next(cur)) return;
    bool has_next = S.next(nxt);
    unsigned gcur[2][2] = {{0u, 0u}, {0u, 0u}};
    if constexpr (GATHER) {
        if (tid < 256) TBL[tid] = S.row_off(cur, tid);
        __syncthreads();
#pragma unroll
        for (int h = 0; h < 2; ++h)
#pragma unroll
            for (int i = 0; i < 2; ++i) gcur[h][i] = TBL[h * 128 + i * 64 + rowA] + (unsigned)colA2;
        __syncthreads();
        tn = TB2;
        if (has_next && tid < 256) TBL[tn + tid] = S.row_off(nxt, tid);
        if (has_next) has_nn = S.next(nn);
        __syncthreads();
    }
    f32x4 acc[2][2][4][2];
#pragma unroll
    for (int a = 0; a < 2; ++a)
#pragma unroll
        for (int b = 0; b < 2; ++b)
#pragma unroll
            for (int m = 0; m < 4; ++m)
#pragma unroll
                for (int n = 0; n < 2; ++n) acc[a][b][m][n] = (f32x4){0.f, 0.f, 0.f, 0.f};
    bf16x8 At[4][2], B0[2][2], B1[2][2];
    const GAS char* cA = S.a_ptr(cur); const GAS char* cB = S.b_ptr(cur);
    unsigned bpar = 0u;
#define PG8_BIAS(unit) do { if (wid == 0) { const GAS float* bs_ = E.bias_src(unit, lane); if (bs_) __builtin_amdgcn_global_load_lds((const GAS unsigned*)bs_, (LAS unsigned*)(lds + L_GM + bpar * 1024u), 16, 0, 0); } } while (0)
    PG8_BIAS(cur);
    PG8_STAGE(PG8_SB(0, 0), cB, voffB); PG8_STAGE(PG8_SB(0, 1), cB + hstep, voffB); PG8_STAGE_A(PG8_SA(0, 0), cA, 0, gcur); PG8_STAGE_A(PG8_SA(0, 1), cA, 1, gcur);
    if (wr == 1) PG8_BAR;
    PG8_WAIT_V(2); PG8_BAR;
    PG8_STAGE(PG8_SB(1, 0), cB + kstep, voffB); PG8_STAGE_A(PG8_SA(1, 0), cA + kstep, 0, gcur); PG8_STAGE(PG8_SB(1, 1), cB + hstep + kstep, voffB);
    PG8_WAIT_V(6); PG8_BAR;
    for (;;) {
        const GAS char* nA = has_next ? S.a_ptr(nxt) : cA; const GAS char* nB = has_next ? S.b_ptr(nxt) : cB;
#pragma unroll 1
        for (int t = 0; t < nt; t += 2) {
            const bool last = (t == nt - 2);
            const GAS char* a1 = cA + (size_t)(t + 1) * kstep;
            const GAS char* a2 = last ? nA : cA + (size_t)(t + 2) * kstep; const GAS char* b2 = last ? nB : cB + (size_t)(t + 2) * kstep;
            const GAS char* a3 = a2 + kstep; const GAS char* b3 = b2 + kstep;
            unsigned g2[2][2];
            if constexpr (GATHER) {
#pragma unroll
                for (int h = 0; h < 2; ++h)
#pragma unroll
                    for (int i = 0; i < 2; ++i) g2[h][i] = gcur[h][i];
                if (last && has_next) {
#pragma unroll
                    for (int h = 0; h < 2; ++h)
#pragma unroll
                        for (int i = 0; i < 2; ++i) g2[h][i] = TBL[tn + h * 128 + i * 64 + rowA] + (unsigned)colA2;
                }
            }
            PG8_LDB(B0, 0, 0); PG8_LDB(B1, 0, 1); PG8_SCHED; PG8_LDA(At, 0, 0); PG8_STAGE_A(PG8_SA(1, 1), a1, 1, gcur);
            PG8_WAIT_V(8); PG8_WAIT_L(0); PG8_BAR; PG8_MMA(0, 0, At, B0); PG8_MMA(0, 1, At, B1); PG8_BAR; PG8_SCHED;
            PG8_LDA(At, 0, 1); PG8_STAGE(PG8_SB(0, 0), b2, voffB); PG8_STAGE(PG8_SB(0, 1), b2 + hstep, voffB); PG8_STAGE_A(PG8_SA(0, 0), a2, 0, g2);
            PG8_WAIT_V(8); PG8_WAIT_L(0); PG8_BAR; PG8_MMA(1, 0, At, B0); PG8_MMA(1, 1, At, B1); PG8_BAR; PG8_SCHED;
            PG8_LDB(B0, 1, 0); PG8_LDB(B1, 1, 1); PG8_SCHED; PG8_LDA(At, 1, 0); PG8_STAGE_A(PG8_SA(0, 1), a2, 1, g2);
            PG8_WAIT_V(8); PG8_WAIT_L(0); PG8_BAR; PG8_MMA(0, 0, At, B0); PG8_MMA(0, 1, At, B1); PG8_BAR; PG8_SCHED;
            PG8_LDA(At, 1, 1); PG8_STAGE(PG8_SB(1, 0), b3, voffB); PG8_STAGE(PG8_SB(1, 1), b3 + hstep, voffB); PG8_STAGE_A(PG8_SA(1, 0), a3, 0, g2);
            PG8_WAIT_V(8); PG8_WAIT_L(0); PG8_BAR; PG8_MMA(1, 0, At, B0); PG8_MMA(1, 1, At, B1); PG8_BAR; PG8_SCHED;
        }
        if (wr == 0) PG8_BAR;
        unsigned pre_off = 0u;
        if constexpr (GATHER) { if (has_next && has_nn && tid < 256) pre_off = S.row_off(nn, tid); }
        if constexpr (FP8) asm volatile("s_nop 15\n\ts_nop 15" ::: "memory");
        { int tz = threadIdx.x; asm volatile("" : "+v"(tz)); const int ln2 = tz & 63; E(acc, cur, wr, wc, ln2 & 15, ln2 >> 4, (const LAS float*)(lds + L_GM + bpar * 1024u)); }
        if (!has_next) break;
#pragma unroll
        for (int a = 0; a < 2; ++a)
#pragma unroll
            for (int b = 0; b < 2; ++b)
#pragma unroll
                for (int m = 0; m < 4; ++m)
#pragma unroll
                    for (int n = 0; n < 2; ++n) acc[a][b][m][n] = (f32x4){0.f, 0.f, 0.f, 0.f};
        cur = nxt; cA = nA; cB = nB;
        bpar ^= 1u; PG8_BIAS(cur);
        if constexpr (GATHER) {
#pragma unroll
            for (int h = 0; h < 2; ++h)
#pragma unroll
                for (int i = 0; i < 2; ++i) gcur[h][i] = TBL[tn + h * 128 + i * 64 + rowA] + (unsigned)colA2;
            tn ^= TB2;
            has_next = has_nn;
            if (has_next) { nxt = nn; if (tid < 256) TBL[tn + tid] = pre_off; has_nn = S.next(nn); }
        } else {
            has_next = S.next(nxt);
        }
        if (wr == 1) PG8_BAR;
    }
    PG8_WAIT_V(0);
    PG8_BAR;
#undef PG8_SA
#undef PG8_SB
#undef PG8_STAGE
#undef PG8_STAGE_A
#undef PG8_STAGE_G
#undef PG8_LDA
#undef PG8_LDB
#undef PG8_MMA
#undef PG8_WAIT_V
#undef PG8_WAIT_L
#undef PG8_BAR
#undef PG8_SCHED
#undef PG8_BIAS
}

template <bool FP8_>
struct DenseSchedT {
    static constexpr bool GATHER = false, FP8 = FP8_; static constexpr int SCALE_A = 0x7f7f7f7f, SCALE_B = FP8_ ? 0x7a7a7a7a : 0x7f7f7f7f;
    static constexpr int ROWB = FP8_ ? GK : GK * 2;
    const GAS char* A; const GAS char* Bt; int nM, nN, nwg, G, c, i;
    DI void init(const GAS void* A_, const GAS void* Bt_, int M, int N, int G_, int c_) { A = (const GAS char*)A_; Bt = (const GAS char*)Bt_; nM = M / BM; nN = N / BM; nwg = nM * nN; G = G_; c = c_; i = 0; }
    DI bool next(GUnit& u) {
        const long L = (long)i * G + c; ++i; if (L >= nwg) return false;
        int wgid = (int)L; { const int q = nwg / 8, r = nwg % 8, xcd = wgid % 8, off = wgid / 8; wgid = (xcd < r ? xcd * (q + 1) : r * (q + 1) + (xcd - r) * q) + off; }
        const int nig = 8 * nN, gid = wgid / nig, fm = gid * 8, gsz = (nM - fm) < 8 ? (nM - fm) : 8;
        const int pm = fm + ((wgid % nig) % gsz); u.pn = (wgid % nig) / gsz; u.row0 = pm * BM; u.e = 0; u.aux = 0; return true;
    }
    DI const GAS char* a_ptr(const GUnit& u) const { return A + (size_t)u.row0 * ROWB; }
    DI const GAS char* b_ptr(const GUnit& u) const { return Bt + (size_t)u.pn * (BM * ROWB); }
    DI unsigned row_off(const GUnit&, int) const { return 0u; }
};

typedef DenseSchedT<false> DenseSched;
typedef DenseSchedT<true> DenseSched8;
#ifndef G1_FP8_FROM
#define G1_FP8_FROM 0
#endif
template <bool GATHER_, int NCT, int NB  >
struct MoeSched {
    static constexpr bool GATHER = GATHER_, FP8 = true; static constexpr int SCALE_A = 0x7f7f7f7f, SCALE_B = 0x7a7a7a7a;
    static constexpr int ROWB = GK;
    const GAS char* A; const GAS char* Bt; const GAS int* slot_tok; LAS unsigned char* lds; int G, c, i, nrt, ltot;
    DI void init(const GAS void* A_, const GAS void* Bt_, const GAS int* st, LAS unsigned char* lds_, int G_, int c_) {
        A = (const GAS char*)A_; Bt = (const GAS char*)Bt_; slot_tok = st; lds = lds_; G = G_; c = c_; i = 0;
        nrt = __builtin_amdgcn_readfirstlane(((LAS int*)(lds + L_TPRE))[32]); ltot = ((nrt + 7) / 8) * 8 * NCT;
    }
    DI bool next(GUnit& u) {
        for (;;) {
            const int L = i * G + c; ++i; if (L >= ltot) return false;
            const int q = L / (8 * NCT), r = L % (8 * NCT), rt = q * 8 + (r & 7), ct = r >> 3;
            if (rt >= nrt) continue;
            const int e = __builtin_amdgcn_readfirstlane((int)((LAS unsigned char*)(lds + L_RT2E))[rt]);
            const int tp = __builtin_amdgcn_readfirstlane(((LAS int*)(lds + L_TPRE))[e]);
            u.row0 = rt * 256; u.pn = ct; u.e = e; u.aux = rt - tp; return true;
        }
    }
    DI const GAS char* a_ptr(const GUnit& u) const { return GATHER ? A : A + (size_t)u.row0 * ROWB; }
    DI const GAS char* b_ptr(const GUnit& u) const { return Bt + ((size_t)u.e * NB + (size_t)u.pn * BM) * ROWB; }
    DI unsigned row_off(const GUnit& u, int r) const {
        const int cnt = ((LAS int*)(lds + L_CNT))[u.e]; const int pos = u.aux * 256 + r;
        const int tok = pos < cnt ? slot_tok[(size_t)u.e * ECAP + pos] : 0;
        return (unsigned)tok * (unsigned)ROWB;
    }
};

struct EpiProj {
    static constexpr bool PERM = true;
    GAS bf16_t* O;
    DI const GAS float* bias_src(const GUnit&, int) const { return nullptr; }
    DI void operator()(const f32x4 (&acc)[2][2][4][2], const GUnit& u, int wr, int wc, int fr, int fq, const LAS float*) const {
        const int row0 = u.row0 + wr * 64 + fr, col0 = u.pn * BM + wc * 32 + 8 * fq;
        const int act = u.pn >= 10 ? 2 : 0;
#pragma unroll
        for (int ai = 0; ai < 2; ++ai)
#pragma unroll
            for (int m = 0; m < 4; ++m) { GAS bf16_t* rowp = O + (size_t)(row0 + ai * HALF + m * 16) * INC + col0;
#pragma unroll
                for (int bj = 0; bj < 2; ++bj) { f32x4 v0 = acc[ai][bj][m][0], v1 = acc[ai][bj][m][1];
                    if (act == 1) {
#pragma unroll
                        for (int j = 0; j < 4; ++j) { v0[j] = gelu_tanh(v0[j]); v1[j] = gelu_tanh(v1[j]); } }
                    else if (act == 2) {
#pragma unroll
                        for (int j = 0; j < 4; ++j) { v0[j] = silu_f(v0[j]); v1[j] = silu_f(v1[j]); } }
                    u32x4 w; w.x = pk2(v0[0], v0[1]); w.y = pk2(v0[2], v0[3]); w.z = pk2(v1[0], v1[1]); w.w = pk2(v1[2], v1[3]);
                    *(GAS u32x4*)(rowp + bj * HALF) = w; } }
    }
};
#define SCHEDB_E() __builtin_amdgcn_sched_barrier(0)
struct EpiResid {
    static constexpr bool PERM = true;
    const GAS float* xin32; const GAS bf16_t* xin16; GAS bf16_t* xout; const GAS float* gate;
    DI const GAS float* bias_src(const GUnit& u, int lane) const { return gate + (size_t)(u.row0 / SEQ) * (NMOD * D) + u.pn * BM + 4 * lane; }
    DI void operator()(const f32x4 (&acc)[2][2][4][2], const GUnit& u, int wr, int wc, int fr, int fq, const LAS float* BL) const {
        const int row0 = u.row0 + wr * 64 + fr, col0 = u.pn * BM + wc * 32 + 8 * fq;
        f32x4 gv[2][2];
#pragma unroll
        for (int bj = 0; bj < 2; ++bj)
#pragma unroll
            for (int n = 0; n < 2; ++n) gv[bj][n] = *(const LAS f32x4*)(BL + wc * 32 + 8 * fq + bj * HALF + 4 * n);
        if (xin32) {
#pragma unroll
            for (int ai = 0; ai < 2; ++ai)
#pragma unroll
            for (int mh = 0; mh < 2; ++mh) { f32x4 xa[2][2][2];
#pragma unroll
                for (int mm = 0; mm < 2; ++mm) { const size_t off = (size_t)(row0 + ai * HALF + (2 * mh + mm) * 16) * D + col0;
#pragma unroll
                    for (int bj = 0; bj < 2; ++bj) { xa[mm][bj][0] = *(const GAS f32x4*)(xin32 + off + bj * HALF); xa[mm][bj][1] = *(const GAS f32x4*)(xin32 + off + bj * HALF + 4); } }
                SCHEDB_E();
#pragma unroll
                for (int mm = 0; mm < 2; ++mm) { const int m = 2 * mh + mm; const size_t off = (size_t)(row0 + ai * HALF + m * 16) * D + col0;
#pragma unroll
                    for (int bj = 0; bj < 2; ++bj) { const f32x4 v0 = xa[mm][bj][0] + gv[bj][0] * acc[ai][bj][m][0], v1 = xa[mm][bj][1] + gv[bj][1] * acc[ai][bj][m][1];
                        u32x4 w; w.x = pk2(v0[0], v0[1]); w.y = pk2(v0[2], v0[3]); w.z = pk2(v1[0], v1[1]); w.w = pk2(v1[2], v1[3]);
                        *(GAS u32x4*)(xout + off + bj * HALF) = w; } } }
        } else {
#pragma unroll
            for (int ai = 0; ai < 2; ++ai) { u32x4 xr[4][2];
#pragma unroll
                for (int m = 0; m < 4; ++m) { const size_t off = (size_t)(row0 + ai * HALF + m * 16) * D + col0;
#pragma unroll
                    for (int bj = 0; bj < 2; ++bj) xr[m][bj] = *(const GAS u32x4*)(xin16 + off + bj * HALF); }
                SCHEDB_E();
#pragma unroll
                for (int m = 0; m < 4; ++m) { const size_t off = (size_t)(row0 + ai * HALF + m * 16) * D + col0;
#pragma unroll
                    for (int bj = 0; bj < 2; ++bj) { const u32x4 q = xr[m][bj];
                        const f32x4 x0 = (f32x4){bflo(q.x), bfhi(q.x), bflo(q.y), bfhi(q.y)}, x1 = (f32x4){bflo(q.z), bfhi(q.z), bflo(q.w), bfhi(q.w)};
                        const f32x4 v0 = x0 + gv[bj][0] * acc[ai][bj][m][0], v1 = x1 + gv[bj][1] * acc[ai][bj][m][1];
                        u32x4 w; w.x = pk2(v0[0], v0[1]); w.y = pk2(v0[2], v0[3]); w.z = pk2(v1[0], v1[1]); w.w = pk2(v1[2], v1[3]);
                        *(GAS u32x4*)(xout + off + bj * HALF) = w; } } }
        }
    }
};
struct EpiSwiglu {
    static constexpr bool PERM = false;
    GAS unsigned char* O; const GAS float* b1;
    DI const GAS float* bias_src(const GUnit& u, int lane) const { return b1 + (size_t)u.e * (2 * FF) + (lane >> 5) * FF + u.pn * 128 + 4 * (lane & 31); }
    DI void operator()(const f32x4 (&acc)[2][2][4][2], const GUnit& u, int wr, int wc, int fr, int fq, const LAS float* BL) const {
        const int row0 = u.row0 + wr * 64 + fr, ocol = u.pn * 128 + wc * 32 + 8 * fq;
        f32x4 bg[2], bl[2];
#pragma unroll
        for (int bj = 0; bj < 2; ++bj) { bg[bj] = *(const LAS f32x4*)(BL + wc * 32 + 8 * fq + 4 * bj); bl[bj] = *(const LAS f32x4*)(BL + 128 + wc * 32 + 8 * fq + 4 * bj); }
#pragma unroll
        for (int ai = 0; ai < 2; ++ai)
#pragma unroll
            for (int m = 0; m < 4; ++m) { GAS unsigned char* rowp = O + (size_t)(row0 + ai * HALF + m * 16) * FF + ocol;
                f32x4 o[2];
#pragma unroll
                for (int bj = 0; bj < 2; ++bj) { f32x4 g = acc[ai][bj][m][0] + bg[bj], l = acc[ai][bj][m][1] + bl[bj];
#pragma unroll
                    for (int j = 0; j < 4; ++j) { g[j] = fminf(g[j], 7.0f); l[j] = __builtin_amdgcn_fmed3f(l[j], -7.0f, 7.0f); }
                    f32x4 e = g * (-1.702f * 1.4426950408889634f);
#pragma unroll
                    for (int j = 0; j < 4; ++j) e[j] = __builtin_amdgcn_exp2f(e[j]);
                    e = e + 1.0f;
#pragma unroll
                    for (int j = 0; j < 4; ++j) e[j] = __builtin_amdgcn_rcpf(e[j]);
                    const f32x4 p = g * e; o[bj] = p * l + p; }
                u32x2 w; w.x = pk4_fp8(o[0][0], o[0][1], o[0][2], o[0][3]); w.y = pk4_fp8(o[1][0], o[1][1], o[1][2], o[1][3]);
                *(GAS u32x2*)rowp = w; }
    }
};
struct EpiY {
    static constexpr bool PERM = false;
    GAS unsigned char* O; const GAS float* b2;
    DI const GAS float* bias_src(const GUnit& u, int lane) const { return b2 + (size_t)u.e * D + u.pn * BM + 4 * lane; }
    DI void operator()(const f32x4 (&acc)[2][2][4][2], const GUnit& u, int wr, int wc, int fr, int fq, const LAS float* BL) const {
        const int row0 = u.row0 + wr * 64 + fr, col0 = u.pn * BM + wc * 64 + 16 * fq;
        f32x4 bv[2][2];
#pragma unroll
        for (int bj = 0; bj < 2; ++bj)
#pragma unroll
            for (int n = 0; n < 2; ++n) bv[bj][n] = *(const LAS f32x4*)(BL + wc * 64 + 16 * fq + 8 * bj + 4 * n);
#pragma unroll
        for (int ai = 0; ai < 2; ++ai)
#pragma unroll
            for (int m = 0; m < 4; ++m) { GAS unsigned char* rowp = O + (size_t)(row0 + ai * HALF + m * 16) * D + col0;
                unsigned w4[4];
#pragma unroll
                for (int bj = 0; bj < 2; ++bj)
#pragma unroll
                    for (int n = 0; n < 2; ++n) { const f32x4 v = acc[ai][bj][m][n] + bv[bj][n]; w4[2 * bj + n] = pk4_fp8(clamp8(v[0]), clamp8(v[1]), clamp8(v[2]), clamp8(v[3])); }
                *(GAS u32x4*)rowp = (u32x4){w4[0], w4[1], w4[2], w4[3]}; }
    }
};

DI void p0_mod(const Frame& F0) {
    Frame F = F0; F.ws = launder_s(F0.ws); F.in = launder_s(F0.in); { int t_ = F0.tid; asm volatile("" : "+v"(t_)); F.tid = t_; F.lane = t_ & 63; int c_ = __builtin_amdgcn_readfirstlane(F0.c); asm volatile("" : "+s"(c_)); F.c = c_; }
    const GAS float* c = F.in[I_C]; const GAS float* wada = F.in[I_WADA]; const GAS float* bada = F.in[I_BADA];
    GAS float* mod = (GAS float*)(F.ws + WS_MOD);
    LAS float* ca = (LAS float*)F.lds;
    for (int it = F.c; it < DEPTH * 12 * 4; it += F.G) {
        const int l = it / 48, r = it % 48, jb = r / 4, bg = r % 4;
        __syncthreads();
        for (int u = F.tid; u < 8 * 1024; u += NTHR) { const int bb = u >> 10, i = u & 1023; ca[i * 8 + bb] = silu_f(c[(size_t)(bg * 8 + bb) * D + i]); }
        __syncthreads();
        const int q = F.tid >> 7, cg = F.tid & 127;
        const GAS float* wp = wada + (size_t)l * D * (NMOD * D) + jb * 512 + 4 * cg;
        f32x4 a[8];
#pragma unroll
        for (int bb = 0; bb < 8; ++bb) a[bb] = (f32x4){0.f, 0.f, 0.f, 0.f};
#pragma unroll 8
        for (int i = 256 * q; i < 256 * q + 256; ++i) { const f32x4 w = *(const GAS f32x4*)(wp + (size_t)i * (NMOD * D)); const f32x4 c0 = *(const LAS f32x4*)(ca + i * 8), c1 = *(const LAS f32x4*)(ca + i * 8 + 4);
            a[0] += w * c0[0]; a[1] += w * c0[1]; a[2] += w * c0[2]; a[3] += w * c0[3]; a[4] += w * c1[0]; a[5] += w * c1[1]; a[6] += w * c1[2]; a[7] += w * c1[3]; }
        LAS float* red = (LAS float*)(F.lds + 32768);
#pragma unroll
        for (int bb = 0; bb < 8; ++bb) *(LAS f32x4*)(red + (q * 8 + bb) * 512 + 4 * cg) = a[bb];
        __syncthreads();
        const int j = jb * 512 + F.tid;
        const float bj = bada[(size_t)l * (NMOD * D) + j];
#pragma unroll
        for (int bb = 0; bb < 8; ++bb) { const float s = (red[(0 * 8 + bb) * 512 + F.tid] + red[(1 * 8 + bb) * 512 + F.tid]) + (red[(2 * 8 + bb) * 512 + F.tid] + red[(3 * 8 + bb) * 512 + F.tid]);
            mod[((size_t)l * BATCH + bg * 8 + bb) * (NMOD * D) + j] = s + bj; }
    }
    __syncthreads();
}
DI void p0_tables(const Frame& F0) {
    Frame F = F0; F.ws = launder_s(F0.ws); F.in = launder_s(F0.in); { int t_ = F0.tid; asm volatile("" : "+v"(t_)); F.tid = t_; F.lane = t_ & 63; int c_ = __builtin_amdgcn_readfirstlane(F0.c); asm volatile("" : "+s"(c_)); F.c = c_; }
    const int gt = F.c * NTHR + F.tid, NGT = F.G * NTHR;
    const GAS float* wsp = F.in[I_WSP]; GAS bf16_t* wst = (GAS bf16_t*)(F.ws + WS_WST);
    for (int u = gt; u < DEPTH * 4 * 128 * 128; u += NGT) { const int s = u & 127, t = (u >> 7) & 127; wst[u] = (bf16_t)(s <= t ? f2bf(wsp[u]) : 0u); }
    const GAS float* wr = F.in[I_WR]; GAS bf16_t* wri = (GAS bf16_t*)(F.ws + WS_WRT);
    for (int u = gt; u < DEPTH * NE * D; u += NGT) { const int i = u & 1023, e = (u >> 10) & 31, ll = u >> 15; const float w = wr[((size_t)ll * D + i) * NE + e];
        const unsigned hi = f2bf(w); const unsigned lo = f2bf(w - __builtin_bit_cast(float, hi << 16));
        GAS bf16_t* img = wri + (size_t)ll * (WRI_BYTES / 2); img[e * (WRI_ROWB / 2) + i] = (bf16_t)hi; img[32 * (WRI_ROWB / 2) + e * (WRI_ROWB / 2) + i] = (bf16_t)lo; }
}
template <int MODE  >
DI void transpose_item(const GAS float* W, int N, GAS bf16_t* WT, LAS float* scr, int item, int lane) {
    constexpr int K = 1024;
    const int nblk = N / 32, kb = item / nblk, nb = item % nblk, k0 = 64 * kb, n0 = 32 * nb;
    const int c4 = lane & 7, kr = lane >> 3;
    f32x4 v[8];
#pragma unroll
    for (int i = 0; i < 8; ++i) v[i] = __builtin_nontemporal_load((const GAS f32x4*)(W + (size_t)(k0 + kr + 8 * i) * N + n0 + 4 * c4));
#pragma unroll
    for (int i = 0; i < 8; ++i) { LAS float* d = scr + (kr + 8 * i) * 33 + 4 * c4; d[0] = v[i].x; d[1] = v[i].y; d[2] = v[i].z; d[3] = v[i].w; }
    asm volatile("s_waitcnt lgkmcnt(0)" ::: "memory");
    const int cc = lane & 7;
#pragma unroll
    for (int j = 0; j < 4; ++j) { const int n = (lane >> 3) + 8 * j; const LAS float* s = scr + (8 * cc) * 33 + n;
        u32x4 o; o.x = pk2(s[0 * 33], s[1 * 33]); o.y = pk2(s[2 * 33], s[3 * 33]); o.z = pk2(s[4 * 33], s[5 * 33]); o.w = pk2(s[6 * 33], s[7 * 33]);
        int dr = n0 + n;
        if (MODE == 1) { const int sc = dr, nn = sc >> 10, g = sc & 1023, pn = g >> 7, wc = (g >> 5) & 3, fq = (g >> 3) & 3, bj = (g >> 2) & 1, jj = g & 3;
            dr = 256 * pn + 128 * bj + 32 * wc + 16 * nn + 4 * fq + jj; }
        *(GAS u32x4*)(WT + (size_t)dr * K + k0 + 8 * cc) = o; }
    asm volatile("s_waitcnt lgkmcnt(0)" ::: "memory");
}
template <int MODE>
DI void transpose_item8(const GAS float* W, int N, GAS unsigned char* WT, LAS float* scr, int item, int lane) {
    constexpr int K = 1024;
    const int nblk = N / 32, kb = item / nblk, nb = item % nblk, k0 = 64 * kb, n0 = 32 * nb;
    const int c4 = lane & 7, kr = lane >> 3;
    f32x4 v[8];
#pragma unroll
    for (int i = 0; i < 8; ++i) v[i] = __builtin_nontemporal_load((const GAS f32x4*)(W + (size_t)(k0 + kr + 8 * i) * N + n0 + 4 * c4));
#pragma unroll
    for (int i = 0; i < 8; ++i) { LAS float* d = scr + (kr + 8 * i) * 33 + 4 * c4; d[0] = v[i].x; d[1] = v[i].y; d[2] = v[i].z; d[3] = v[i].w; }
    asm volatile("s_waitcnt lgkmcnt(0)" ::: "memory");
    const int kq = lane & 3;
#pragma unroll
    for (int j = 0; j < 2; ++j) { const int n = (lane >> 2) + 16 * j; const LAS float* s = scr + (16 * kq) * 33 + n;
        float f[16];
#pragma unroll
        for (int e = 0; e < 16; ++e) f[e] = clamp8(s[e * 33] * 32.0f);
        u32x4 o; o.x = pk4_fp8(f[0], f[1], f[2], f[3]); o.y = pk4_fp8(f[4], f[5], f[6], f[7]); o.z = pk4_fp8(f[8], f[9], f[10], f[11]); o.w = pk4_fp8(f[12], f[13], f[14], f[15]);
        int dr = n0 + n;
        if (MODE == 1) { const int sc = dr, nn = sc >> 10, g = sc & 1023, pn = g >> 7, wc = (g >> 5) & 3, fq = (g >> 3) & 3, bj = (g >> 2) & 1, jj = g & 3;
            dr = 256 * pn + 128 * bj + 32 * wc + 16 * nn + 4 * fq + jj; }
        if (MODE == 2) { const int sc = dr, c = sc & 255, wc = c >> 6, fq = (c >> 4) & 3, bj = (c >> 3) & 1, nn = (c >> 2) & 1, jj = c & 3;
            dr = (sc & ~255) + 128 * bj + 32 * wc + 16 * nn + 4 * fq + jj; }
        __builtin_nontemporal_store(o, (GAS u32x4*)(WT + (size_t)dr * K + k0 + 16 * kq)); }
    asm volatile("s_waitcnt lgkmcnt(0)" ::: "memory");
}
template <int MODE>
DI void transpose_item8w(const GAS float* W, int N, GAS unsigned char* WT, LAS float* scr, int item, int lane) {
    constexpr int K = 1024;
    const int nblk = N / 32, kb = item / nblk, nb = item % nblk, k0 = 128 * kb, n0 = 32 * nb;
    const int c4 = lane & 7, kr = lane >> 3;
    f32x4 v[16];
#pragma unroll
    for (int i = 0; i < 16; ++i) v[i] = __builtin_nontemporal_load((const GAS f32x4*)(W + (size_t)(k0 + kr + 8 * i) * N + n0 + 4 * c4));
#pragma unroll
    for (int i = 0; i < 16; ++i) { LAS float* d = scr + (kr + 8 * i) * 33 + 4 * c4; d[0] = v[i].x; d[1] = v[i].y; d[2] = v[i].z; d[3] = v[i].w; }
    asm volatile("s_waitcnt lgkmcnt(0)" ::: "memory");
    const int kq = lane & 7;
#pragma unroll
    for (int j = 0; j < 4; ++j) { const int n = (lane >> 3) + 8 * j; const LAS float* s = scr + (16 * kq) * 33 + n;
        float f[16];
#pragma unroll
        for (int e = 0; e < 16; ++e) f[e] = clamp8(s[e * 33] * 32.0f);
        u32x4 o; o.x = pk4_fp8(f[0], f[1], f[2], f[3]); o.y = pk4_fp8(f[4], f[5], f[6], f[7]); o.z = pk4_fp8(f[8], f[9], f[10], f[11]); o.w = pk4_fp8(f[12], f[13], f[14], f[15]);
        int dr = n0 + n;
        if (MODE == 1) { const int sc = dr, nn = sc >> 10, g = sc & 1023, pn = g >> 7, wc = (g >> 5) & 3, fq = (g >> 3) & 3, bj = (g >> 2) & 1, jj = g & 3;
            dr = 256 * pn + 128 * bj + 32 * wc + 16 * nn + 4 * fq + jj; }
        if (MODE == 2) { const int sc = dr, c = sc & 255, wc = c >> 6, fq = (c >> 4) & 3, bj = (c >> 3) & 1, nn = (c >> 2) & 1, jj = c & 3;
            dr = (sc & ~255) + 128 * bj + 32 * wc + 16 * nn + 4 * fq + jj; }
        __builtin_nontemporal_store(o, (GAS u32x4*)(WT + (size_t)dr * K + k0 + 16 * kq)); }
    asm volatile("s_waitcnt lgkmcnt(0)" ::: "memory");
}
#define SCHEDB_() __builtin_amdgcn_sched_barrier(0)
template <bool H8>
DI void modnorm_rows(const Frame& F, const GAS float* xsrc, GAS bf16_t* hdst, int row_first, int nrows  , const GAS float* g, const GAS float* sc, const GAS float* sh) {
    f32x4 gm[4], sv[4];
#pragma unroll
    for (int j = 0; j < 4; ++j) { const f32x4 gg = *(const GAS f32x4*)(g + 4 * F.lane + 256 * j), ss = *(const GAS f32x4*)(sc + 4 * F.lane + 256 * j); gm[j] = gg * (ss + 1.0f); sv[j] = *(const GAS f32x4*)(sh + 4 * F.lane + 256 * j); }
    auto ld = [&](f32x4 (&v)[4], size_t row) {
#pragma unroll
        for (int j = 0; j < 4; ++j) v[j] = __builtin_nontemporal_load((const GAS f32x4*)(xsrc + row * D) + F.lane + 64 * j); };
    auto put = [&](const f32x4 (&v)[4], size_t row) {
        float s = 0.f;
#pragma unroll
        for (int j = 0; j < 4; ++j) s += (v[j].x * v[j].x + v[j].y * v[j].y) + (v[j].z * v[j].z + v[j].w * v[j].w);
        const float rstd = 1.0f / sqrtf(wave_sum(s) * (1.f / D) + EPS);
        GAS u32x2* o8 = (GAS u32x2*)(hdst + row * D) + F.lane; GAS unsigned* o4 = (GAS unsigned*)((GAS unsigned char*)hdst + row * D) + F.lane;
#pragma unroll
        for (int j = 0; j < 4; ++j) { const f32x4 h = v[j] * rstd * gm[j] + sv[j];
            if (H8) o4[64 * j] = pk4_fp8(clamp8(h.x), clamp8(h.y), clamp8(h.z), clamp8(h.w));
            else { u32x2 w; w.x = pk2(h.x, h.y); w.y = pk2(h.z, h.w); o8[64 * j] = w; } } };
    f32x4 va[4], vb[4];
    ld(va, (size_t)row_first);
    for (int r = 0; r < nrows; r += 2) {
        const size_t row = (size_t)(row_first + r);
        ld(vb, row + 1); SCHEDB_();
        put(va, row);
        ld(va, r + 2 < nrows ? row + 2 : row); SCHEDB_();
        put(vb, row + 1);
    }
}
DI void p1_prologue(const Frame& F0) {
    Frame F = F0; F.ws = launder_s(F0.ws); F.in = launder_s(F0.in); { int t_ = F0.tid; asm volatile("" : "+v"(t_)); F.tid = t_; F.lane = t_ & 63; int c_ = __builtin_amdgcn_readfirstlane(F0.c); asm volatile("" : "+s"(c_)); F.c = c_; }
    LAS float* scr = (LAS float*)(F.lds + (F.wave < 7 ? F.wave * 16896 : L_TINFO));
    const int gw = F.c * NWAVES + F.wave, NGW = F.G * NWAVES;
    const GAS float* win = F.in[I_WIN]; const GAS float* wout = F.in[I_WOUT]; const GAS float* w1 = F.in[I_W1]; const GAS float* w2 = F.in[I_W2];
    GAS bf16_t* win_t = (GAS bf16_t*)(F.ws + WS_WIN); GAS bf16_t* wout_t = (GAS bf16_t*)(F.ws + WS_WOUT); GAS bf16_t* w1_t = (GAS bf16_t*)(F.ws + WS_W1); GAS bf16_t* w2_t = (GAS bf16_t*)(F.ws + WS_W2);
    for (int it = gw; it < DEPTH * 16 * 96; it += NGW) { const int mat = it / 1536, r = it % 1536;
        if (mat >= G1_FP8_FROM) transpose_item8<0>(win + (size_t)mat * D * INC, INC, (GAS unsigned char*)(win_t + (size_t)mat * INC * D), scr, r, F.lane);
        else transpose_item<0>(win + (size_t)mat * D * INC, INC, win_t + (size_t)mat * INC * D, scr, r, F.lane); }
    for (int it = gw; it < DEPTH * 16 * 32; it += NGW) { const int mat = it / 512, r = it % 512; transpose_item<0>(wout + (size_t)mat * D * D, D, wout_t + (size_t)mat * D * D, scr, r, F.lane); }
    for (int it = gw; it < DEPTH * NE * 8 * 64; it += NGW) { const int mat = it / 512, r = it % 512; transpose_item8w<1>(w1 + (size_t)mat * D * 2 * FF, 2 * FF, (GAS unsigned char*)w1_t + (size_t)mat * 2 * FF * D, scr, r, F.lane); }
    for (int it = gw; it < DEPTH * NE * 8 * 32; it += NGW) { const int mat = it / 256, r = it % 256; transpose_item8w<2>(w2 + (size_t)mat * FF * D, D, (GAS unsigned char*)w2_t + (size_t)mat * D * FF, scr, r, F.lane); }
    const GAS float* mod = (const GAS float*)(F.ws + WS_MOD);
    for (int blk = gw; blk < T / 32; blk += NGW) { const int row0 = blk * 32, b = row0 / SEQ; const GAS float* mb = mod + (size_t)b * (NMOD * D);
        modnorm_rows<(0 >= G1_FP8_FROM)>(F, F.in[I_X], (GAS bf16_t*)(F.ws + WS_H), row0, 32, F.in[I_GMIX], mb + 1 * D, mb + 0 * D); }
}

DI unsigned img_off(unsigned row, unsigned ch) { return 256u * row + 16u * (ch ^ (((row & 3u) << 2) | ((row >> 2) & 3u))); }
DI s16x4 tr4(LAS unsigned char* img, unsigned rowg, unsigned cb, unsigned q, unsigned p) {
    return __builtin_amdgcn_ds_read_tr16_b64_v4i16((LAS s16x4*)(img + img_off(rowg + q, 2u * cb + (p >> 1)) + 8u * (p & 1u)));
}
DI bf16x8 cat8(s16x4 lo, s16x4 hi) { return __builtin_shufflevector(lo, hi, 0, 1, 2, 3, 4, 5, 6, 7); }
#define MFMA16(a, b, c) __builtin_amdgcn_mfma_f32_16x16x32_bf16((a), (b), (c), 0, 0, 0)

struct MixLane { unsigned rbase, trA0, trA1, trB, wbase; };
DI MixLane mix_lane(int lane, int w) {
    const unsigned fr = lane & 15, fq = lane >> 4, q = fr >> 2, p = fr & 3;
    MixLane L;
    L.rbase = 256u * fr + 64u * (fr & 3u) + 16u * (fq ^ ((fr >> 2) & 3u));
    const unsigned XA = (q << 1) | (fq & 1u);
    L.trA0 = 2048u * fq + 256u * q + 32u * XA + 16u * (p >> 1) + 8u * (p & 1u);
    L.trA1 = 2048u * fq + 1024u + 256u * q + 32u * XA + 16u * ((p >> 1) ^ 1u) + 8u * (p & 1u);
    const unsigned XB = (q << 1) | (fq >> 1);
    L.trB = 1024u * fq + 256u * q + 32u * XB + 16u * ((p >> 1) ^ (fq & 1u)) + 8u * (p & 1u);
    const unsigned XW = ((fr & 3u) << 1) | ((fr >> 3) & 1u);
    L.wbase = 4096u * (unsigned)w + 256u * fr + 32u * XW + 16u * ((fq >> 1) ^ ((fr >> 2) & 1u)) + 8u * (fq & 1u);
    return L;
}
DI s16x4 trr(LAS unsigned char* img, unsigned a) { return __builtin_amdgcn_ds_read_tr16_b64_v4i16((LAS s16x4*)(img + a)); }
#define SCHEDB() __builtin_amdgcn_sched_barrier(0)

#define LDS_BARRIER() do { asm volatile("s_waitcnt lgkmcnt(0)" ::: "memory"); __builtin_amdgcn_s_barrier(); asm volatile("" ::: "memory"); } while (0)
DI void mix_gmlp_unit(const Frame& F0, int l, int b, int n) {
    Frame F = F0; F.ws = launder_s(F0.ws); F.in = launder_s(F0.in); { int t_ = F0.tid; asm volatile("" : "+v"(t_)); F.tid = t_; F.lane = t_ & 63; int c_ = __builtin_amdgcn_readfirstlane(F0.c); asm volatile("" : "+s"(c_)); F.c = c_; }
    const GAS bf16_t* proj = (const GAS bf16_t*)(F.ws + WS_PROJ); GAS bf16_t* mix = (GAS bf16_t*)(F.ws + WS_MIX);
    const GAS bf16_t* wst = (const GAS bf16_t*)(F.ws + WS_WST) + (size_t)l * 4 * 128 * 128;
    const GAS float* lng = F.in[I_LNG] + l * 512; const GAS float* lnb = F.in[I_LNB] + l * 512; const GAS float* bsp = F.in[I_BSP] + l * 512;
    const size_t grow0 = (size_t)b * SEQ + (size_t)n * CHUNK;
    int lane_ = F.lane; asm volatile("" : "+v"(lane_));
    const int lane = lane_, w = F.wave, fr = lane & 15, fq = lane >> 4;
    const MixLane ML = mix_lane(lane, w);
    LDS_BARRIER();
    {
        float g8[8], b8[8];
#pragma unroll
        for (int e = 0; e < 8; ++e) { g8[e] = lng[8 * lane + e]; b8[e] = lnb[8 * lane + e]; }
        LAS unsigned char* img = F.lds + (lane >> 4) * 32768;
        for (int i4 = 0; i4 < 16; i4 += 4) { u32x4 raw4[4];
#pragma unroll
            for (int k = 0; k < 4; ++k) raw4[k] = *(const GAS u32x4*)(proj + (grow0 + 16 * w + i4 + k) * INC + 512 + 8 * lane);
#pragma unroll
            for (int k = 0; k < 4; ++k) { const int row = 16 * w + i4 + k; const u32x4 raw = raw4[k];
            float x[8]; x[0] = bflo(raw.x); x[1] = bfhi(raw.x); x[2] = bflo(raw.y); x[3] = bfhi(raw.y); x[4] = bflo(raw.z); x[5] = bfhi(raw.z); x[6] = bflo(raw.w); x[7] = bfhi(raw.w);
            float s = 0.f;
#pragma unroll
            for (int e = 0; e < 8; ++e) { x[e] = gelu_tanh(x[e]); s += x[e]; }
            const float mean = wave_sum(s) * (1.0f / 512.0f); float s2 = 0.f;
#pragma unroll
            for (int e = 0; e < 8; ++e) { x[e] -= mean; s2 += x[e] * x[e]; }
            const float rstd = 1.0f / sqrtf(wave_sum(s2) * (1.0f / 512.0f) + EPS);
#pragma unroll
            for (int e = 0; e < 8; ++e) x[e] = x[e] * rstd * g8[e] + b8[e];
            u32x4 o; o.x = pk2(x[0], x[1]); o.y = pk2(x[2], x[3]); o.z = pk2(x[4], x[5]); o.w = pk2(x[6], x[7]);
            *(LAS u32x4*)(img + img_off(row, lane & 15)) = o; } }
    }
    LDS_BARRIER();
    const int t = 16 * w + fr;
    const int ncs = (16 * w + 15) / 32 + 1;
    for (int hd = 0; hd < 4; ++hd) {
        LAS unsigned char* img = F.lds + hd * 32768;
        bf16x8 wf[4];
#pragma unroll
        for (int c = 0; c < 4; ++c) wf[c] = *(const GAS bf16x8*)(wst + ((size_t)hd * 128 + t) * 128 + 32 * c + 8 * fq);
        const float bs = bsp[hd * 128 + t];
        f32x4 acc[8];
#pragma unroll
        for (int m = 0; m < 8; ++m) acc[m] = (f32x4){0.f, 0.f, 0.f, 0.f};
#pragma unroll
        for (int c = 0; c < 4; ++c) { if (c < ncs) {
#pragma unroll
            for (int m = 0; m < 8; ++m) { const bf16x8 a = cat8(trr(img, (ML.trA0 ^ (32u * m)) + 8192u * c), trr(img, (ML.trA1 ^ (32u * m)) + 8192u * c)); acc[m] = MFMA16(a, wf[c], acc[m]); } } }
        const GAS bf16_t* up = proj + (grow0 + t) * INC + 128 * hd + 4 * fq; GAS bf16_t* op = mix + (grow0 + t) * D + 128 * hd + 4 * fq;
        u32x2 uu8[8];
#pragma unroll
        for (int m = 0; m < 8; ++m) uu8[m] = *(const GAS u32x2*)(up + 16 * m);
#pragma unroll
        for (int m = 0; m < 8; ++m) { const u32x2 uu = uu8[m];
            const float o0 = gelu_tanh(bflo(uu.x)) * (acc[m][0] + bs), o1 = gelu_tanh(bfhi(uu.x)) * (acc[m][1] + bs), o2 = gelu_tanh(bflo(uu.y)) * (acc[m][2] + bs), o3 = gelu_tanh(bfhi(uu.y)) * (acc[m][3] + bs);
            u32x2 o; o.x = pk2(o0, o1); o.y = pk2(o2, o3); *(GAS u32x2*)(op + 16 * m) = o; }
    }
}

DI void mix_ret_unit(const Frame& F0, int l, int b, int h) {
    Frame F = F0; F.ws = launder_s(F0.ws); F.in = launder_s(F0.in); { int t_ = F0.tid; asm volatile("" : "+v"(t_)); F.tid = t_; F.lane = t_ & 63; int c_ = __builtin_amdgcn_readfirstlane(F0.c); asm volatile("" : "+s"(c_)); F.c = c_; }
    const GAS bf16_t* proj = (const GAS bf16_t*)(F.ws + WS_PROJ); GAS bf16_t* mix = (GAS bf16_t*)(F.ws + WS_MIX);
    const GAS float* rng = F.in[I_RNG] + l * 512 + h * 128;
    const int w = (F.wave < 4) ? 2 * F.wave : 15 - 2 * F.wave;
    LAS unsigned char* IS = F.lds + 0; LAS unsigned char* IK = F.lds + 32768; LAS unsigned char* IV = F.lds + 65536; LAS unsigned char* IQ = F.lds + 98304;
    const float lg2 = log2f(1.0f - exp2f(-5.0f - (float)h));
    const float g1 = exp2f(lg2), g127 = exp2f(127.0f * lg2), g128 = exp2f(128.0f * lg2);
    f32x4 st[8];
#pragma unroll
    for (int m = 0; m < 8; ++m) st[m] = (f32x4){0.f, 0.f, 0.f, 0.f};
    LDS_BARRIER();
    for (int u = F.tid; u < 32768 / 16; u += NTHR) *(LAS u32x4*)(IS + 16 * u) = (u32x4){0u, 0u, 0u, 0u};
    LAS float* RG = (LAS float*)(F.lds + L_GM);
    if (F.tid < 128) RG[F.tid] = rng[F.tid];
    u32x4 rq[2][2], rk[2][2], rv[2][2];
#define RET_LOAD(n_) do { int tid2 = F.tid; asm volatile("" : "+v"(tid2)); const int r0_ = tid2 >> 3, cc_ = tid2 & 7; \
        _Pragma("unroll") for (int i = 0; i < 2; ++i) { const GAS bf16_t* pr = proj + ((size_t)b * SEQ + (size_t)(n_) * CHUNK + r0_ + 64 * i) * INC + 128 * h + 8 * cc_; \
            rq[i][0] = *(const GAS u32x4*)(pr + 1024); rq[i][1] = *(const GAS u32x4*)(pr + 1024 + 64); rk[i][0] = *(const GAS u32x4*)(pr + 1536); rk[i][1] = *(const GAS u32x4*)(pr + 1536 + 64); \
            rv[i][0] = *(const GAS u32x4*)(pr + 2048); rv[i][1] = *(const GAS u32x4*)(pr + 2048 + 64); } } while (0)
    RET_LOAD(0);
    for (int n = 0; n < NCHUNK; ++n) {
        const size_t grow0 = (size_t)b * SEQ + (size_t)n * CHUNK;
        u32x2 gg[8];
        { int l0 = F.lane; asm volatile("" : "+v"(l0)); const GAS bf16_t* gp = proj + (grow0 + 16 * w + (l0 & 15)) * INC + 2560 + 128 * h + 4 * (l0 >> 4);
#pragma unroll
            for (int m = 0; m < 8; ++m) gg[m] = *(const GAS u32x2*)(gp + 16 * m); }
        {
            int tid2 = F.tid; asm volatile("" : "+v"(tid2));
            const int r0 = tid2 >> 3, cc = tid2 & 7;
            float itf[8];
#pragma unroll
            for (int e = 0; e < 8; ++e) itf[e] = __builtin_amdgcn_exp2f(-(float)(8 * cc + e) * (13.287712379549449f / 64.0f)) * 0.15915494309189535f;
#pragma unroll
            for (int i = 0; i < 2; ++i) { const int row = r0 + 64 * i; const float pos = (float)(n * CHUNK + row);
                float cs[8], sn[8];
#pragma unroll
                for (int e = 0; e < 8; ++e) { const float tt = pos * itf[e]; const float fr = __builtin_amdgcn_fractf(tt); cs[e] = __builtin_amdgcn_cosf(fr); sn[e] = __builtin_amdgcn_sinf(fr); }
#pragma unroll
                for (int which = 0; which < 2; ++which) {
                    const u32x4 lo = which ? rk[i][0] : rq[i][0], hi = which ? rk[i][1] : rq[i][1];
                    const unsigned lw[4] = {lo.x, lo.y, lo.z, lo.w}, hw[4] = {hi.x, hi.y, hi.z, hi.w};
                    float a[8], bb[8];
#pragma unroll
                    for (int e = 0; e < 4; ++e) { a[2 * e] = bflo(lw[e]); a[2 * e + 1] = bfhi(lw[e]); bb[2 * e] = bflo(hw[e]); bb[2 * e + 1] = bfhi(hw[e]); }
                    const float sc = which ? 0.08838834764831845f : 1.0f;
                    float ra[8], rb[8];
#pragma unroll
                    for (int e = 0; e < 8; ++e) { ra[e] = (a[e] * cs[e] - bb[e] * sn[e]) * sc; rb[e] = (a[e] * sn[e] + bb[e] * cs[e]) * sc; }
                    LAS unsigned char* img = which ? IK : IQ;
                    u32x4 o; o.x = pk2(ra[0], ra[1]); o.y = pk2(ra[2], ra[3]); o.z = pk2(ra[4], ra[5]); o.w = pk2(ra[6], ra[7]);
                    *(LAS u32x4*)(img + img_off(row, cc)) = o;
                    o.x = pk2(rb[0], rb[1]); o.y = pk2(rb[2], rb[3]); o.z = pk2(rb[4], rb[5]); o.w = pk2(rb[6], rb[7]);
                    *(LAS u32x4*)(img + img_off(row, cc + 8)) = o; }
                const float vs = __builtin_amdgcn_exp2f(-(float)row * lg2);
#pragma unroll
                for (int half = 0; half < 2; ++half) { const u32x4 vv = rv[i][half];
                    u32x4 o; o.x = pk2(bflo(vv.x) * vs, bfhi(vv.x) * vs); o.y = pk2(bflo(vv.y) * vs, bfhi(vv.y) * vs); o.z = pk2(bflo(vv.z) * vs, bfhi(vv.z) * vs); o.w = pk2(bflo(vv.w) * vs, bfhi(vv.w) * vs);
                    *(LAS u32x4*)(IV + img_off(row, cc + 8 * half)) = o; } }
        }
        if (n + 1 < NCHUNK) RET_LOAD(n + 1);
        LDS_BARRIER();
        int lane_ = F.lane; asm volatile("" : "+v"(lane_));
        const int lane = lane_, fr = lane & 15, fq = lane >> 4, t = 16 * w + fr;
        const MixLane ML = mix_lane(lane, w);
        const float gt = __builtin_amdgcn_exp2f((float)t * lg2);
        bf16x8 qf[4];
#pragma unroll
        for (int c = 0; c < 4; ++c) qf[c] = *(const LAS bf16x8*)(IQ + ((ML.rbase ^ (64u * c)) + 4096u * (unsigned)w));
        f32x4 accS[8];
#pragma unroll
        for (int a = 0; a < 8; ++a) { accS[a] = (f32x4){0.f, 0.f, 0.f, 0.f};
            if (a <= w) {
#pragma unroll
                for (int c = 0; c < 4; ++c) { const bf16x8 kf = *(const LAS bf16x8*)(IK + ((ML.rbase ^ (64u * c)) + 4096u * a)); accS[a] = MFMA16(kf, qf[c], accS[a]); }
                if (a == w) {
#pragma unroll
                    for (int j = 0; j < 4; ++j) if (4 * fq + j > fr) accS[a][j] = 0.f; } } }
        SCHEDB();
        f32x4 accO[8];
#pragma unroll
        for (int m = 0; m < 8; ++m) accO[m] = (f32x4){0.f, 0.f, 0.f, 0.f};
#pragma unroll
        for (int c = 0; c < 4; ++c) { if (2 * c <= w) {
            u32x4 pw; pw.x = pk2(accS[2 * c][0], accS[2 * c][1]); pw.y = pk2(accS[2 * c][2], accS[2 * c][3]); pw.z = pk2(accS[2 * c + 1][0], accS[2 * c + 1][1]); pw.w = pk2(accS[2 * c + 1][2], accS[2 * c + 1][3]);
            const bf16x8 pf = __builtin_bit_cast(bf16x8, pw);
#pragma unroll
            for (int m = 0; m < 8; ++m) { const bf16x8 vf = cat8(trr(IV, (ML.trB ^ (32u * m)) + 8192u * c), trr(IV, (ML.trB ^ (32u * m)) + 8192u * c + 4096u)); accO[m] = MFMA16(vf, pf, accO[m]); }
            SCHEDB(); } }
#pragma unroll
        for (int c = 0; c < 4; ++c) {
#pragma unroll
            for (int m = 0; m < 8; ++m) { const bf16x8 sf = cat8(trr(IS, (ML.trA0 ^ (32u * m)) + 8192u * c), trr(IS, (ML.trA1 ^ (32u * m)) + 8192u * c)); accO[m] = MFMA16(sf, qf[c], accO[m]); }
            SCHEDB(); }
        {
            float ss = 0.f;
#pragma unroll
            for (int m = 0; m < 8; ++m) { accO[m] = accO[m] * gt; ss += (accO[m][0] * accO[m][0] + accO[m][1] * accO[m][1]) + (accO[m][2] * accO[m][2] + accO[m][3] * accO[m][3]); }
            ss += __shfl_xor(ss, 16); ss += __shfl_xor(ss, 32);
            const float rstd = 1.0f / sqrtf(ss * (1.0f / 128.0f) + EPS);
            GAS bf16_t* op = mix + (grow0 + t) * D + 512 + 128 * h + 4 * fq;
#pragma unroll
            for (int m = 0; m < 8; ++m) { const f32x4 rg = *(const LAS f32x4*)(RG + 16 * m + 4 * fq);
                const float o0 = accO[m][0] * rstd * rg[0] * bflo(gg[m].x), o1 = accO[m][1] * rstd * rg[1] * bfhi(gg[m].x), o2 = accO[m][2] * rstd * rg[2] * bflo(gg[m].y), o3 = accO[m][3] * rstd * rg[3] * bfhi(gg[m].y);
                u32x2 o; o.x = pk2(o0, o1); o.y = pk2(o2, o3); *(GAS u32x2*)(op + 16 * m) = o; }
        }
        SCHEDB();
        {
            bf16x8 kt[4];
#pragma unroll
            for (int c = 0; c < 4; ++c) kt[c] = cat8(trr(IK, (ML.trA0 ^ (32u * (unsigned)w)) + 8192u * c), trr(IK, (ML.trA1 ^ (32u * (unsigned)w)) + 8192u * c));
#pragma unroll
            for (int m = 0; m < 8; ++m) { f32x4 kv = (f32x4){0.f, 0.f, 0.f, 0.f};
#pragma unroll
                for (int c = 0; c < 4; ++c) { const bf16x8 vf = cat8(trr(IV, (ML.trA0 ^ (32u * m)) + 8192u * c), trr(IV, (ML.trA1 ^ (32u * m)) + 8192u * c)); kv = MFMA16(vf, kt[c], kv); }
                st[m] = st[m] * g128 + kv * g127; SCHEDB(); }
        }
        LDS_BARRIER();
#pragma unroll
        for (int m = 0; m < 8; ++m) { u32x2 o; o.x = pk2(st[m][0] * g1, st[m][1] * g1); o.y = pk2(st[m][2] * g1, st[m][3] * g1);
            *(LAS u32x2*)(IS + (ML.wbase ^ (32u * m))) = o; }
    }
#undef RET_LOAD
    LDS_BARRIER();
}

DI void mix_phase(const Frame& F0, int l) {
    Frame F = F0; { int c_ = __builtin_amdgcn_readfirstlane(F0.c); asm volatile("" : "+s"(c_)); F.c = c_; }
    const int NR = BATCH * 4, NGM = BATCH * NCHUNK;
    if (F.G >= 2 * NR) {
        if (F.c < NR) mix_ret_unit(F, l, F.c >> 2, F.c & 3);
        else for (int it = F.c - NR; it < NGM; it += F.G - NR) mix_gmlp_unit(F, l, it / NCHUNK, it % NCHUNK);
    } else {
        for (int it = F.c; it < NR; it += F.G) mix_ret_unit(F, l, it >> 2, it & 3);
        for (int it = F.c; it < NGM; it += F.G) mix_gmlp_unit(F, l, it / NCHUNK, it % NCHUNK);
    }
    __syncthreads();
}

DI void n2_phase(const Frame& F0, int l) {
    Frame F = F0; F.ws = launder_s(F0.ws); F.in = launder_s(F0.in); { int t_ = F0.tid; asm volatile("" : "+v"(t_)); F.tid = t_; F.lane = t_ & 63; int c_ = __builtin_amdgcn_readfirstlane(F0.c); asm volatile("" : "+s"(c_)); F.c = c_; }
    const GAS bf16_t* x1 = (const GAS bf16_t*)(F.ws + WS_XA);
    const GAS float* br = F.in[I_BR] + l * NE;
    const GAS float* mod = (const GAS float*)(F.ws + WS_MOD) + (size_t)l * BATCH * (NMOD * D);
    GAS unsigned char* H8 = (GAS unsigned char*)(F.ws + WS_H);
    GAS int* tokinfo = (GAS int*)(F.ws + WS_TOKINFO); GAS float* tokw = (GAS float*)(F.ws + WS_TOKW); GAS int* slot_tok = (GAS int*)(F.ws + WS_SLOTTOK);
    GAS unsigned* gcnt = (GAS unsigned*)(F.ws + WS_CTL) + CW_CNT + l * 64;
    LAS int* lcnt = (LAS int*)(F.lds + L_LCNT); LAS int* lbase = (LAS int*)(F.lds + L_BASE);
    LAS int* tinfo = (LAS int*)(F.lds + L_TINFO); LAS float* tw = (LAS float*)(F.lds + L_TW);
    LAS float* GM = (LAS float*)(F.lds + L_GM); LAS float* SV = (LAS float*)(F.lds + L_SV);
    const int lane = F.lane, ri = lane & 15, g = lane >> 4;
    __syncthreads();
    {
        const GAS u32x4* src = (const GAS u32x4*)(F.ws + WS_WRT + (size_t)l * WRI_BYTES);
        for (int u0 = F.tid; u0 < WRI_BYTES / 16; u0 += 6 * NTHR) { u32x4 t6[6];
#pragma unroll
            for (int k = 0; k < 6; ++k) { const int u = u0 + k * NTHR; t6[k] = src[u < WRI_BYTES / 16 ? u : u0]; }
#pragma unroll
            for (int k = 0; k < 6; ++k) { const int u = u0 + k * NTHR; if (u < WRI_BYTES / 16) ((LAS u32x4*)F.lds)[u] = t6[k]; } }
    }
    const float brl0 = br[ri], brl1 = br[16 + ri];
    for (int blk = F.c; blk < T / 256; blk += F.G) {
        const int tok0 = blk * 256, b = tok0 / SEQ; const GAS float* mb = mod + (size_t)b * (NMOD * D);
        __syncthreads();
        if (F.tid < 32) lcnt[F.tid] = 0;
        for (int i = F.tid; i < D; i += NTHR) { GM[i] = F.in[I_GFFN][l * D + i] * (1.0f + mb[4 * D + i]); SV[i] = mb[3 * D + i]; }
        __syncthreads();
#pragma unroll 1
        for (int mt = 0; mt < 2; ++mt) {
            const int tl = F.wave * 32 + mt * 16 + ri;
            const GAS bf16_t* xrow = x1 + (size_t)(tok0 + tl) * D + 8 * g;
            float ss = 0.f;
            { u32x4 v[32];
#pragma unroll
                for (int k = 0; k < 32; ++k) v[k] = *(const GAS u32x4*)(xrow + 32 * k);
#pragma unroll
                for (int k = 0; k < 32; ++k) { const float a0 = bflo(v[k].x), a1 = bfhi(v[k].x), a2 = bflo(v[k].y), a3 = bfhi(v[k].y), a4 = bflo(v[k].z), a5 = bfhi(v[k].z), a6 = bflo(v[k].w), a7 = bfhi(v[k].w);
                    ss += ((a0 * a0 + a1 * a1) + (a2 * a2 + a3 * a3)) + ((a4 * a4 + a5 * a5) + (a6 * a6 + a7 * a7)); } }
            ss += __shfl_xor(ss, 16); ss += __shfl_xor(ss, 32);
            const float rstd = 1.0f / sqrtf(ss * (1.f / D) + EPS);
            f32x4 acc0 = (f32x4){0.f, 0.f, 0.f, 0.f}, acc1 = acc0;
            GAS unsigned char* hrow = H8 + (size_t)(tok0 + tl) * D + 8 * g;
            u32x4 ra[8], rb[8];
#pragma unroll
            for (int k = 0; k < 8; ++k) ra[k] = *(const GAS u32x4*)(xrow + 32 * k);
#pragma unroll 1
            for (int kb = 0; kb < 4; ++kb) {
            const int kn = kb < 3 ? kb + 1 : kb;
#pragma unroll
            for (int k = 0; k < 8; ++k) rb[k] = *(const GAS u32x4*)(xrow + 32 * (8 * kn + k));
            SCHEDB();
#pragma unroll
            for (int k = 0; k < 8; ++k) { const int kk = 8 * kb + k;
                const u32x4 raw = ra[k];
                const f32x4 g0 = *(const LAS f32x4*)(GM + 32 * kk + 8 * g), g1 = *(const LAS f32x4*)(GM + 32 * kk + 8 * g + 4), s0 = *(const LAS f32x4*)(SV + 32 * kk + 8 * g), s1 = *(const LAS f32x4*)(SV + 32 * kk + 8 * g + 4);
                float h[8]; h[0] = bflo(raw.x) * rstd * g0[0] + s0[0]; h[1] = bfhi(raw.x) * rstd * g0[1] + s0[1]; h[2] = bflo(raw.y) * rstd * g0[2] + s0[2]; h[3] = bfhi(raw.y) * rstd * g0[3] + s0[3];
                h[4] = bflo(raw.z) * rstd * g1[0] + s1[0]; h[5] = bfhi(raw.z) * rstd * g1[1] + s1[1]; h[6] = bflo(raw.w) * rstd * g1[2] + s1[2]; h[7] = bfhi(raw.w) * rstd * g1[3] + s1[3];
                u32x2 f8; f8.x = pk4_fp8(clamp8(h[0]), clamp8(h[1]), clamp8(h[2]), clamp8(h[3])); f8.y = pk4_fp8(clamp8(h[4]), clamp8(h[5]), clamp8(h[6]), clamp8(h[7]));
                *(GAS u32x2*)(hrow + 32 * kk) = f8;
                u32x4 hi, lo; hi.x = pk2(h[0], h[1]); hi.y = pk2(h[2], h[3]); hi.z = pk2(h[4], h[5]); hi.w = pk2(h[6], h[7]);
                lo.x = pk2(h[0] - bflo(hi.x), h[1] - bfhi(hi.x)); lo.y = pk2(h[2] - bflo(hi.y), h[3] - bfhi(hi.y)); lo.z = pk2(h[4] - bflo(hi.z), h[5] - bfhi(hi.z)); lo.w = pk2(h[6] - bflo(hi.w), h[7] - bfhi(hi.w));
                const bf16x8 ahi = __builtin_bit_cast(bf16x8, hi), alo = __builtin_bit_cast(bf16x8, lo);
                const LAS unsigned char* wp = F.lds + ri * WRI_ROWB + (32 * kk + 8 * g) * 2;
                const bf16x8 wh0 = *(const LAS bf16x8*)(wp), wh1 = *(const LAS bf16x8*)(wp + 16 * WRI_ROWB), wl0 = *(const LAS bf16x8*)(wp + 32 * WRI_ROWB), wl1 = *(const LAS bf16x8*)(wp + 48 * WRI_ROWB);
                acc0 = MFMA16(ahi, wh0, acc0); acc0 = MFMA16(alo, wh0, acc0); acc0 = MFMA16(ahi, wl0, acc0);
                acc1 = MFMA16(ahi, wh1, acc1); acc1 = MFMA16(alo, wh1, acc1); acc1 = MFMA16(ahi, wl1, acc1);
            }
#pragma unroll
            for (int k = 0; k < 8; ++k) ra[k] = rb[k];
            }
#pragma unroll
            for (int jj = 0; jj < 4; ++jj) {
                float v0 = acc0[jj] + brl0, v1 = acc1[jj] + brl1; int se[4]; float sv4[4];
#pragma unroll
                for (int k = 0; k < 4; ++k) {
                    float bv = v0 >= v1 ? v0 : v1; int bi = v0 >= v1 ? ri : 16 + ri;
#pragma unroll
                    for (int o = 1; o < 16; o <<= 1) { const float ov = __shfl_xor(bv, o); const int oi = __shfl_xor(bi, o); const bool take = (ov > bv) || (ov == bv && oi < bi); bv = take ? ov : bv; bi = take ? oi : bi; }
                    se[k] = bi; sv4[k] = bv; v0 = (bi == ri) ? -3.0e38f : v0; v1 = (bi == 16 + ri) ? -3.0e38f : v1; }
                if (ri == 0) {
                    float ex[4], sum = 0.f;
#pragma unroll
                    for (int k = 0; k < 4; ++k) { ex[k] = __expf(sv4[k] - sv4[0]); sum += ex[k]; }
                    const float inv = 1.0f / sum; const int tt = F.wave * 32 + mt * 16 + 4 * g + jj;
#pragma unroll
                    for (int k = 0; k < 4; ++k) { const int rank = __hip_atomic_fetch_add(lcnt + se[k], 1, __ATOMIC_RELAXED, __HIP_MEMORY_SCOPE_WORKGROUP);
                        tinfo[tt * 4 + k] = (se[k] << 17) | rank; tw[tt * 4 + k] = ex[k] * inv; } }
            }
        }
        __syncthreads();
        if (F.tid < 32) lbase[F.tid] = (int)__hip_atomic_fetch_add(gcnt + F.tid, (unsigned)lcnt[F.tid], __ATOMIC_RELAXED, __HIP_MEMORY_SCOPE_AGENT);
        __syncthreads();
        if (F.tid < 256) { const int tok = tok0 + F.tid;
#pragma unroll
            for (int k = 0; k < 4; ++k) { const int ti = tinfo[F.tid * 4 + k]; const int e = ti >> 17, pos = lbase[e] + (ti & 0x1ffff);
                slot_tok[(size_t)e * ECAP + pos] = tok; tokinfo[tok * 4 + k] = (e << 17) | pos; tokw[tok * 4 + k] = tw[F.tid * 4 + k]; } }
    }
    __syncthreads();
}

DI void moe_tables(const Frame& F0, int l) {
    Frame F = F0; F.ws = launder_s(F0.ws); F.in = launder_s(F0.in); { int t_ = F0.tid; asm volatile("" : "+v"(t_)); F.tid = t_; F.lane = t_ & 63; int c_ = __builtin_amdgcn_readfirstlane(F0.c); asm volatile("" : "+s"(c_)); F.c = c_; }
    const GAS unsigned* gcnt = (const GAS unsigned*)(F.ws + WS_CTL) + CW_CNT + l * 64;
    LAS int* cnt = (LAS int*)(F.lds + L_CNT); LAS int* tpre = (LAS int*)(F.lds + L_TPRE); LAS unsigned char* rt2e = F.lds + L_RT2E;
    __syncthreads();
    if (F.tid < 32) cnt[F.tid] = (int)__hip_atomic_load(gcnt + F.tid, __ATOMIC_RELAXED, __HIP_MEMORY_SCOPE_AGENT);
    __syncthreads();
    if (F.tid == 0) { int s = 0; for (int e = 0; e < 32; ++e) { tpre[e] = s; s += (cnt[e] + 255) >> 8; } tpre[32] = s; }
    __syncthreads();
    const int nrt = tpre[32];
    for (int rt = F.tid; rt < nrt; rt += NTHR) { int e = 0; for (int k = 1; k < 32; ++k) e += (tpre[k] <= rt) ? 1 : 0; rt2e[rt] = (unsigned char)e; }
    __syncthreads();
}

DI void combine_phase(const Frame& F0, int l) {
    Frame F = F0; F.ws = launder_s(F0.ws); F.in = launder_s(F0.in); { int t_ = F0.tid; asm volatile("" : "+v"(t_)); F.tid = t_; F.lane = t_ & 63; int c_ = __builtin_amdgcn_readfirstlane(F0.c); asm volatile("" : "+s"(c_)); F.c = c_; }
    const GAS bf16_t* x1 = (const GAS bf16_t*)(F.ws + WS_XA); GAS bf16_t* x2 = (GAS bf16_t*)(F.ws + WS_XB);
    const GAS unsigned char* Y = (const GAS unsigned char*)(F.ws + WS_Y);
    const GAS int* tokinfo = (const GAS int*)(F.ws + WS_TOKINFO); const GAS float* tokw = (const GAS float*)(F.ws + WS_TOKW);
    const GAS float* mod = (const GAS float*)(F.ws + WS_MOD);
    LAS int* tpre = (LAS int*)(F.lds + L_TPRE);
    const int gw = F.c * NWAVES + F.wave, NGW = F.G * NWAVES, lane = F.lane;
    const bool lastl = (l == DEPTH - 1);
    for (int blk = gw; blk < T / 32; blk += NGW) {
        const int row0 = blk * 32, b = row0 / SEQ;
        const GAS float* mb = mod + ((size_t)l * BATCH + b) * (NMOD * D);
        const GAS float* mn = mod + ((size_t)(lastl ? l : l + 1) * BATCH + b) * (NMOD * D);
        f32x4 gf[2][2], gm[2][2], sv[2][2];
#pragma unroll
        for (int j = 0; j < 2; ++j)
#pragma unroll
            for (int q = 0; q < 2; ++q) { const int col = 512 * j + 8 * lane + 4 * q; gf[j][q] = *(const GAS f32x4*)(mb + 5 * D + col);
                if (lastl) { gm[j][q] = *(const GAS f32x4*)(F.in[I_GFIN] + col); sv[j][q] = (f32x4){0.f, 0.f, 0.f, 0.f}; }
                else { const f32x4 gg = *(const GAS f32x4*)(F.in[I_GMIX] + (l + 1) * D + col), ss = *(const GAS f32x4*)(mn + 1 * D + col); gm[j][q] = gg * (ss + 1.0f); sv[j][q] = *(const GAS f32x4*)(mn + 0 * D + col); } }
        int sl[4]; float wk4[4];
        { const int rr = lane & 31; const u32x4 ti = *(const GAS u32x4*)(tokinfo + (size_t)(row0 + rr) * 4); const f32x4 tw = *(const GAS f32x4*)(tokw + (size_t)(row0 + rr) * 4);
            const unsigned tiw[4] = {ti.x, ti.y, ti.z, ti.w};
#pragma unroll
            for (int k = 0; k < 4; ++k) { const int e = (int)(tiw[k] >> 17), pos = (int)(tiw[k] & 0x1ffffu); sl[k] = tpre[e] * 256 + pos; wk4[k] = tw[k]; } }
        for (int r = 0; r < 32; r += 2) {
            u32x2 yy[2][4][2]; u32x4 xv[2][2]; float wk[2][4];
#pragma unroll
            for (int u = 0; u < 2; ++u) {
#pragma unroll
                for (int k = 0; k < 4; ++k) { const int slot = __builtin_amdgcn_readlane(sl[k], r + u); wk[u][k] = __builtin_bit_cast(float, __builtin_amdgcn_readlane(__builtin_bit_cast(int, wk4[k]), r + u));
                    const GAS u32x2* yr = (const GAS u32x2*)(Y + (size_t)slot * D) + lane;
#pragma unroll
                    for (int j = 0; j < 2; ++j) yy[u][k][j] = __builtin_nontemporal_load(yr + 64 * j); }
                const GAS u32x4* xr = (const GAS u32x4*)(x1 + (size_t)(row0 + r + u) * D) + lane;
#pragma unroll
                for (int j = 0; j < 2; ++j) xv[u][j] = __builtin_nontemporal_load(xr + 64 * j); }
#pragma unroll
            for (int u = 0; u < 2; ++u) {
                const int tok = row0 + r + u;
                f32x4 v[2][2]; float s = 0.f;
#pragma unroll
                for (int j = 0; j < 2; ++j) { f32x4 m0 = (f32x4){0.f, 0.f, 0.f, 0.f}, m1 = m0;
#pragma unroll
                    for (int k = 0; k < 4; ++k) { m0 += unpk4_fp8(yy[u][k][j].x) * wk[u][k]; m1 += unpk4_fp8(yy[u][k][j].y) * wk[u][k]; }
                    const u32x4 xw = xv[u][j];
                    v[j][0] = (f32x4){bflo(xw.x), bfhi(xw.x), bflo(xw.y), bfhi(xw.y)} + gf[j][0] * m0; v[j][1] = (f32x4){bflo(xw.z), bfhi(xw.z), bflo(xw.w), bfhi(xw.w)} + gf[j][1] * m1;
#pragma unroll
                    for (int q = 0; q < 2; ++q) s += (v[j][q].x * v[j][q].x + v[j][q].y * v[j][q].y) + (v[j][q].z * v[j][q].z + v[j][q].w * v[j][q].w); }
                const float rstd = 1.0f / sqrtf(wave_sum(s) * (1.f / D) + EPS);
                if (lastl) { GAS f32x4* o = (GAS f32x4*)(F.out + (size_t)tok * D + 8 * lane);
#pragma unroll
                    for (int j = 0; j < 2; ++j) { __builtin_nontemporal_store(v[j][0] * rstd * gm[j][0], o + 128 * j); __builtin_nontemporal_store(v[j][1] * rstd * gm[j][1], o + 128 * j + 1); } }
                else { GAS u32x4* xo = (GAS u32x4*)(x2 + (size_t)tok * D) + lane; GAS u32x4* ho = (GAS u32x4*)((GAS bf16_t*)(F.ws + WS_H) + (size_t)tok * D) + lane;
#pragma unroll
                    for (int j = 0; j < 2; ++j) { u32x4 xw; xw.x = pk2(v[j][0].x, v[j][0].y); xw.y = pk2(v[j][0].z, v[j][0].w); xw.z = pk2(v[j][1].x, v[j][1].y); xw.w = pk2(v[j][1].z, v[j][1].w); xo[64 * j] = xw;
                        const f32x4 h0 = v[j][0] * rstd * gm[j][0] + sv[j][0], h1 = v[j][1] * rstd * gm[j][1] + sv[j][1];
                        if (l + 1 >= G1_FP8_FROM) { u32x2 h8; h8.x = pk4_fp8(clamp8(h0.x), clamp8(h0.y), clamp8(h0.z), clamp8(h0.w)); h8.y = pk4_fp8(clamp8(h1.x), clamp8(h1.y), clamp8(h1.z), clamp8(h1.w));
                            ((GAS u32x2*)((GAS unsigned char*)(F.ws + WS_H) + (size_t)tok * D) + lane)[64 * j] = h8; }
                        else { u32x4 hw; hw.x = pk2(h0.x, h0.y); hw.y = pk2(h0.z, h0.w); hw.z = pk2(h1.x, h1.y); hw.w = pk2(h1.z, h1.w); ho[64 * j] = hw; } } }
            }
        }
    }
}

constexpr int N_PHASES = 2 + 7 * DEPTH;
__global__ void __launch_bounds__(NTHR, 2) fwd_kernel(Args args) {
    extern __shared__ __attribute__((aligned(16))) unsigned char lds_raw[];
    Frame F;
    F.lds = (LAS unsigned char*)lds_raw; F.ws = (GAS unsigned char*)args.ws; F.out = (GAS float*)args.out;
    F.in = (const GAS float* const CAS*)__builtin_amdgcn_kernarg_segment_ptr();
    F.tid = threadIdx.x; F.lane = F.tid & 63; F.wave = __builtin_amdgcn_readfirstlane(F.tid >> 6);
    F.G = gridDim.x; F.c = blockIdx.x;
    const int lo = args.ph_lo, hi = args.ph_hi;
    if (F.tid < 4) ((LAS unsigned*)(F.lds + L_MISC))[F.tid] = 0u;
    __syncthreads();
    XcdBarrier bar; bar.bar = (GAS unsigned*)(F.ws + WS_CTL) + CW_BAR; bar.x = 0; bar.st = (volatile LAS unsigned*)(F.lds + L_MISC);
    if (hi - lo > 1) bar = xcd_barrier_post((GAS unsigned*)(F.ws + WS_CTL) + CW_BAR, (volatile LAS unsigned*)(F.lds + L_MISC));
#define IN(k) (lo <= (k) && (k) < hi)
#define SEAM(k) do { if (IN(k) && IN((k) + 1)) xcd_barrier(bar); } while (0)
#ifndef DUP_PHASE
#define DUP_PHASE -1
#endif
#define REPS(k) for (int rep_ = 0; rep_ < ((DUP_PHASE) == (k) ? 2 : 1); ++rep_)
#define REPBAR() do { if (rep_ == 0 && (DUP_PHASE) >= 0) xcd_barrier(bar); } while (0)

    if (IN(0)) { p0_mod(F); p0_tables(F); }
    SEAM(0);
    if (IN(1)) REPS(8) { p1_prologue(F); if ((DUP_PHASE) == 8) REPBAR(); }
    SEAM(1);
    for (int l = 0; l < DEPTH; ++l) {
        const int pb = 2 + 7 * l;
        if (IN(pb + 0)) REPS(0) {
            GAS unsigned char* ws = launder_s(F.ws);
            EpiProj E{(GAS bf16_t*)(ws + WS_PROJ)};
            if (l >= G1_FP8_FROM) { DenseSched8 S; S.init(ws + WS_H, ws + WS_WIN + (size_t)l * INC * D * 2, T, INC, F.G, F.c); gemm_phase(F.lds, S, E); }
            else { DenseSched S; S.init(ws + WS_H, ws + WS_WIN + (size_t)l * INC * D * 2, T, INC, F.G, F.c); gemm_phase(F.lds, S, E); }
            if ((DUP_PHASE) == 0) REPBAR();
        }
        SEAM(pb + 0);
        if (IN(pb + 1)) REPS(1) { mix_phase(F, l); if ((DUP_PHASE) == 1) REPBAR(); }
        SEAM(pb + 1);
        if (IN(pb + 2)) REPS(2) {
            GAS unsigned char* ws = launder_s(F.ws); const GAS float* const CAS* in = launder_s(F.in);
            const GAS float* xin32 = (l == 0) ? in[I_X] : nullptr;
            DenseSched S; S.init(ws + WS_MIX, ws + WS_WOUT + (size_t)l * D * D * 2, T, D, F.G, F.c);
            EpiResid E{xin32, (const GAS bf16_t*)(ws + WS_XB), (GAS bf16_t*)(ws + WS_XA), (const GAS float*)(ws + WS_MOD) + (size_t)l * BATCH * (NMOD * D) + 2 * D};
            gemm_phase(F.lds, S, E);
            if ((DUP_PHASE) == 2) REPBAR();
        }
        SEAM(pb + 2);
        if (IN(pb + 3)) REPS(3) { n2_phase(F, l); if ((DUP_PHASE) == 3 && rep_ == 0) { xcd_barrier(bar); if (F.c == 0 && F.tid < 32) ((GAS unsigned*)(F.ws + WS_CTL))[CW_CNT + l * 64 + F.tid] = 0u; xcd_barrier(bar); } }
        SEAM(pb + 3);
        if (IN(pb + 4)) REPS(4) {
            moe_tables(F, l);
            GAS unsigned char* ws = launder_s(F.ws); const GAS float* const CAS* in = launder_s(F.in);
            MoeSched<true, 8, 2 * FF> S; S.init(ws + WS_H, ws + WS_W1 + (size_t)l * NE * 2 * FF * D, (const GAS int*)(ws + WS_SLOTTOK), F.lds, F.G, F.c);
            EpiSwiglu E{(GAS unsigned char*)(ws + WS_ACT), in[I_B1] + (size_t)l * NE * 2 * FF};
            gemm_phase(F.lds, S, E);
            if ((DUP_PHASE) == 4) REPBAR();
        }
        SEAM(pb + 4);
        if (IN(pb + 5)) REPS(5) {
            if (!IN(pb + 4)) moe_tables(F, l);
            GAS unsigned char* ws = launder_s(F.ws); const GAS float* const CAS* in = launder_s(F.in);
            MoeSched<false, 4, D> S; S.init(ws + WS_ACT, ws + WS_W2 + (size_t)l * NE * D * FF, (const GAS int*)(ws + WS_SLOTTOK), F.lds, F.G, F.c);
            EpiY E{(GAS unsigned char*)(ws + WS_Y), in[I_B2] + (size_t)l * NE * D};
            gemm_phase(F.lds, S, E);
            if ((DUP_PHASE) == 5) REPBAR();
        }
        SEAM(pb + 5);
        if (IN(pb + 6)) REPS(6) { if (!IN(pb + 4)) moe_tables(F, l); combine_phase(F, l); if ((DUP_PHASE) == 6) REPBAR(); }
        SEAM(pb + 6);
    }
#undef IN
#undef SEAM
}
}

extern "C" void kernel_launch(void* const* d_in, const int* in_sizes, int n_in, void* d_out, int out_size, void* d_ws, size_t ws_size, hipStream_t stream) {
    static int grid = 0;
    if (grid == 0) {
        if (n_in != 20 || in_sizes[0] != T * D || out_size != T * D || ws_size < WS_END) { fprintf(stderr, "kernel_launch: unexpected shapes (n_in %d, in0 %d, out %d, ws %zu < %zu)\n", n_in, n_in > 0 ? in_sizes[0] : -1, out_size, ws_size, (size_t)WS_END); grid = -1; return; }
        int dev = 0, cus = 0, per_cu = 0;
        if (hipGetDevice(&dev) != hipSuccess || hipDeviceGetAttribute(&cus, hipDeviceAttributeMultiprocessorCount, dev) != hipSuccess) { grid = -1; return; }
        if (hipFuncSetAttribute((const void*)fwd_kernel, hipFuncAttributeMaxDynamicSharedMemorySize, LDS_BYTES) != hipSuccess) { fprintf(stderr, "kernel_launch: hipFuncSetAttribute failed\n"); grid = -1; return; }
        if (hipOccupancyMaxActiveBlocksPerMultiprocessor(&per_cu, (const void*)fwd_kernel, NTHR, LDS_BYTES) != hipSuccess || per_cu < 1) { fprintf(stderr, "kernel_launch: occupancy query says %d\n", per_cu); }
        (void)hipGetLastError();
        grid = cus;
    }
    if (grid < 0) return;
    (void)hipMemsetAsync((char*)d_ws + WS_CTL, 0, CTL_BYTES, stream);
    Args a{};
    for (int i = 0; i < 20; ++i) a.in[i] = (const float*)d_in[i];
    a.out = (float*)d_out; a.ws = (unsigned char*)d_ws;
#if MK_LAUNCH_PER_PHASE
    for (int p = 0; p < N_PHASES; ++p) { a.ph_lo = p; a.ph_hi = p + 1; hipLaunchKernelGGL(fwd_kernel, dim3(grid), dim3(NTHR), LDS_BYTES, stream, a); }
#else
    a.ph_lo = 0; a.ph_hi = N_PHASES;
    hipLaunchKernelGGL(fwd_kernel, dim3(grid), dim3(NTHR), LDS_BYTES, stream, a);
#endif
}
```

```cpp
#include <hip/hip_runtime.h>
#include <cstdio>
#include <cstdint>
#include <cstddef>

#ifndef MK_LAUNCH_PER_PHASE
#define MK_LAUNCH_PER_PHASE 0
#endif

namespace {
#define LAS __attribute__((address_space(3)))
#define GAS __attribute__((address_space(1)))
#define CAS __attribute__((address_space(4)))
#define DI __device__ __forceinline__
typedef unsigned short bf16_t;
typedef short bf16x8 __attribute__((ext_vector_type(8)));
typedef short s16x4 __attribute__((ext_vector_type(4)));
typedef float f32x4 __attribute__((ext_vector_type(4)));
typedef float f32x2 __attribute__((ext_vector_type(2)));
typedef unsigned u32x4 __attribute__((ext_vector_type(4)));
typedef unsigned u32x2 __attribute__((ext_vector_type(2)));
typedef int i32x8 __attribute__((ext_vector_type(8)));
typedef int i32x4 __attribute__((ext_vector_type(4)));

constexpr int D = 1024, BATCH = 32, SEQ = 2048, DEPTH = 4, T = BATCH * SEQ;
constexpr int CHUNK = 128, NCHUNK = SEQ / CHUNK, INC = 3072, HD = 128;
constexpr int NE = 32, TOPK = 4, FF = 1024, NMOD = 6;
constexpr int NSLOT = T * TOPK + NE * 256;
constexpr int ECAP = T;
constexpr float EPS = 1e-5f;
constexpr int NWAVES = 8, NTHR = 512;

constexpr size_t MiB = 1u << 20;
constexpr size_t WS_CTL = 0, CTL_BYTES = 64 * 1024;
constexpr size_t WS_MOD = 1 * MiB;
constexpr size_t WS_ROPE = 4 * MiB;
constexpr size_t WS_WST = 5 * MiB;
constexpr size_t WS_WRT = 3024 * MiB;
constexpr int WRI_ROWB = 2064, WRI_BYTES = 2 * 32 * WRI_ROWB;
constexpr size_t WS_TOKINFO = 6 * MiB;
constexpr size_t WS_TOKW = 7 * MiB;
constexpr size_t WS_SLOTTOK = 8 * MiB;
constexpr size_t WS_WIN = 16 * MiB;
constexpr size_t WS_WOUT = 40 * MiB;
constexpr size_t WS_W1 = 48 * MiB;
constexpr size_t WS_W2 = 560 * MiB;
constexpr size_t WS_H = 816 * MiB;
constexpr size_t WS_PROJ = 944 * MiB;
constexpr size_t WS_MIX = 1328 * MiB;
constexpr size_t WS_XA = 1456 * MiB;
constexpr size_t WS_XB = 1712 * MiB;
constexpr size_t WS_ACT = 1968 * MiB;
constexpr size_t WS_Y = 2496 * MiB;
constexpr size_t WS_END = 3025 * MiB;
static_assert(WS_WRT + 4 * (size_t)WRI_BYTES <= WS_END, "router image");
static_assert((size_t)NSLOT * 1024 * 2 <= 528 * MiB, "slot buffers");
constexpr int CW_BAR = 1024;
constexpr int CW_CNT = 8192;
static_assert((CW_BAR + 3456) * 4 <= 32768 && (CW_CNT + DEPTH * 64) * 4 <= (int)CTL_BYTES, "control words inside the per-call memset");

constexpr int RING_BYTES = 131072;
constexpr int L_TBL = RING_BYTES;
constexpr int L_MISC = L_TBL + 1024;
constexpr int L_TPRE = L_MISC + 64;
constexpr int L_CNT = L_MISC + 256;
constexpr int L_BASE = L_MISC + 384;
constexpr int L_LCNT = L_MISC + 512;
constexpr int L_RT2E = L_MISC + 1024;
constexpr int L_TINFO = L_MISC + 3200;
constexpr int L_TW = L_TINFO + 4096;
constexpr int L_GM = L_TW + 4096;
constexpr int L_SV = L_GM + 4096;
constexpr int LDS_BYTES = L_SV + 4096 + 512;
static_assert(WRI_BYTES <= L_MISC, "N2's router image must end below the control words");
static_assert(LDS_BYTES <= 160 * 1024 && L_TINFO + 16896 <= LDS_BYTES && 7 * 16896 <= RING_BYTES, "LDS budget");

DI unsigned f2bf(float f) { unsigned u = __builtin_bit_cast(unsigned, f); return (u + 0x7fffu + ((u >> 16) & 1u)) >> 16; }
DI unsigned pk2(float lo, float hi) { unsigned r; asm volatile("v_cvt_pk_bf16_f32 %0, %1, %2" : "=v"(r) : "v"(lo), "v"(hi)); return r; }
DI unsigned pk4_fp8(float a, float b, float c, float d) { int r = 0; r = __builtin_amdgcn_cvt_pk_fp8_f32(a, b, r, false); r = __builtin_amdgcn_cvt_pk_fp8_f32(c, d, r, true); return (unsigned)r; }
DI f32x4 unpk4_fp8(unsigned w) { const f32x2 lo = __builtin_amdgcn_cvt_pk_f32_fp8((int)w, false), hi = __builtin_amdgcn_cvt_pk_f32_fp8((int)w, true); return (f32x4){lo.x, lo.y, hi.x, hi.y}; }
DI float clamp8(float x) { return __builtin_amdgcn_fmed3f(x, -448.0f, 448.0f); }
DI float bflo(unsigned w) { return __builtin_bit_cast(float, w << 16); }
DI float bfhi(unsigned w) { return __builtin_bit_cast(float, w & 0xffff0000u); }
DI float wave_sum(float v) {
#pragma unroll
    for (int o = 1; o < 64; o <<= 1) v += __shfl_xor(v, o);
    return v;
}
DI float gelu_tanh(float x) {
    const float u = x * (1.0f + 0.044715f * x * x) * (-1.5957691216057308f * 1.4426950408889634f);
    return x * __builtin_amdgcn_rcpf(1.0f + __builtin_amdgcn_exp2f(u));
}
DI float silu_f(float x) { return x * __builtin_amdgcn_rcpf(1.0f + __builtin_amdgcn_exp2f(x * -1.4426950408889634f)); }

#define XB_TMO      128
#define XB_XCNT(j)  (256  + 64 * (j))
#define XB_XSUB(j)  (1280 + 64 * (j))
#define XB_XGEN(j)  (2304 + 64 * (j))
#define XB_TOP      3328
#define XB_TOPGEN   3392
#define XCD_BAR_WORDS 3456
#define XB_SPIN_CAP (1u << 22)

DI unsigned xb_ld(GAS unsigned* p)              { return __hip_atomic_load(p, __ATOMIC_RELAXED, __HIP_MEMORY_SCOPE_AGENT); }
DI unsigned xb_add(GAS unsigned* p, unsigned v) { return __hip_atomic_fetch_add(p, v, __ATOMIC_RELAXED, __HIP_MEMORY_SCOPE_AGENT); }
DI unsigned xb_xcc_id() { return (unsigned)__builtin_amdgcn_s_getreg((3 << 11) | 20) & 0xFu; }
#define XB_SPIN(cond, bar) do { unsigned _sp = 0; while (cond) { __builtin_amdgcn_s_sleep(1); \
    if ((++_sp & 255u) == 0u) { if (xb_ld(&(bar)[XB_TMO])) break; if (_sp > XB_SPIN_CAP) { (void)xb_add(&(bar)[XB_TMO], 1u); break; } } } } while (0)

struct XcdBarrier { GAS unsigned* bar; unsigned x; volatile LAS unsigned* st; };

DI XcdBarrier xcd_barrier_post(GAS unsigned* bar, volatile LAS unsigned* st) {
    XcdBarrier b; b.bar = bar; b.x = xb_xcc_id(); b.st = st;
    if (threadIdx.x == 0) (void)xb_add(&bar[XB_XCNT(b.x)], 1u);
    return b;
}
DI void xcd_barrier_complete(GAS unsigned* bar, unsigned x, unsigned& nloc, unsigned& nx) {
    const unsigned G = gridDim.x * gridDim.y * gridDim.z;
    unsigned sum, cnt, mine, sp = 0u;
    for (;;) {
        sum = 0u; cnt = 0u; mine = 0u;
#pragma unroll
        for (unsigned j = 0; j < 16; ++j) { const unsigned c = xb_ld(&bar[XB_XCNT(j)]); sum += c; cnt += (c > 0u) ? 1u : 0u; mine = (j == x) ? c : mine; }
        if (sum == G) break;
        __builtin_amdgcn_s_sleep(1);
        if ((++sp & 255u) == 0u) { if (xb_ld(&bar[XB_TMO])) break; if (sp > XB_SPIN_CAP) { (void)xb_add(&bar[XB_TMO], 1u); break; } }
    }
    nloc = mine > 0u ? mine : 1u; nx = cnt > 0u ? cnt : 1u;
}
DI void xcd_barrier(const XcdBarrier& b) {
    asm volatile("s_waitcnt vmcnt(0)" ::: "memory");
    __syncthreads();
    if (threadIdx.x == 0) {
        GAS unsigned* bar = b.bar;
        __builtin_amdgcn_s_waitcnt(0);
        unsigned nloc = b.st[0], nx = b.st[1];
        if (nloc == 0u) { xcd_barrier_complete(bar, b.x, nloc, nx); b.st[0] = nloc; b.st[1] = nx; }
        const unsigned old = xb_add(&bar[XB_XSUB(b.x)], 1u);
        const unsigned gen = old / nloc;
        if (old + 1u == (gen + 1u) * nloc) {
            __builtin_amdgcn_fence(__ATOMIC_RELEASE, "agent");
            asm volatile("s_waitcnt vmcnt(0)" ::: "memory");
            const unsigned og = xb_add(&bar[XB_TOP], 1u);
            const unsigned tg = og / nx;
            if (og + 1u == (tg + 1u) * nx) xb_add(&bar[XB_TOPGEN], 1u);
            else XB_SPIN(xb_ld(&bar[XB_TOPGEN]) == tg, bar);
            __builtin_amdgcn_fence(__ATOMIC_ACQUIRE, "agent");
            xb_add(&bar[XB_XGEN(b.x)], 1u);
            asm volatile("s_waitcnt vmcnt(0)" ::: "memory");
        } else {
            XB_SPIN(xb_ld(&bar[XB_XGEN(b.x)]) == gen, bar);
            __builtin_amdgcn_fence(__ATOMIC_ACQUIRE, "agent");
            asm volatile("s_waitcnt vmcnt(0)" ::: "memory");
        }
    }
    __syncthreads();
}

struct Args { const float* in[20]; float* out; unsigned char* ws; int ph_lo, ph_hi; };
static_assert(offsetof(Args, in) == 0, "Frame::in reads the kernarg segment from offset 0");
enum { I_X = 0, I_C, I_WADA, I_BADA, I_GMIX, I_WIN, I_LNG, I_LNB, I_WSP, I_BSP, I_RNG, I_WOUT, I_GFFN, I_WR, I_BR, I_W1, I_B1, I_W2, I_B2, I_GFIN };

template <class P> DI P launder_s(P p) { const unsigned long long v = (unsigned long long)p; unsigned lo = __builtin_amdgcn_readfirstlane((unsigned)v), hi = __builtin_amdgcn_readfirstlane((unsigned)(v >> 32));
    asm volatile("" : "+s"(lo), "+s"(hi)); return (P)(((unsigned long long)hi << 32) | lo); }
struct Frame {
    LAS unsigned char* lds;
    GAS unsigned char* ws;
    const GAS float* const CAS* in;
    GAS float* out;
    int tid, lane, wave, G, c;
};

constexpr int BM = 256, BK = 64, HALF = 128, HTB = HALF * BK * 2, GK = 1024;
DI int lds_byte(int r, int c) { const int st = (r >> 4) * 2 + (c >> 5), rr = r & 15, cc = c & 31, ob = rr * 64 + cc * 2; return st * 1024 + (ob ^ (((ob >> 9) & 1) << 5)); }
DI void stage_rc(int b, int& R, int& C) { const int st = b / 1024, sb = b % 1024, swz = sb ^ (((sb >> 9) & 1) << 5); R = (st >> 1) * 16 + swz / 64; C = (st & 1) * 32 + (swz % 64) / 2; }
DI int perm32(int rho) { const int n = rho >> 4, i = rho & 15; return 8 * (i >> 2) + 4 * n + (i & 3); }

struct GUnit { int row0, pn, e, aux; };

template <class Epi, class Sched>
DI void gemm_phase(LAS unsigned char* lds, Sched& S, const Epi& E) {
    int tid_ = threadIdx.x; asm volatile("" : "+v"(tid_));
    const int tid = tid_, wid = __builtin_amdgcn_readfirstlane(tid >> 6), lane = tid & 63, wr = wid >> 2, wc = wid & 3, fr = lane & 15, fq = lane >> 4;
    constexpr bool GATHER = Sched::GATHER, FP8 = Sched::FP8;
    constexpr int ROWB = FP8 ? GK : GK * 2, nt = ROWB / 128;
    unsigned voffA, voffB; int rowA, colA2;
    { int R, C; stage_rc(tid * 16, R, C); const int Rb = Epi::PERM ? ((R & ~31) + perm32(R & 31)) : R;
        voffA = (unsigned)(R * ROWB + C * 2); voffB = (unsigned)(Rb * ROWB + C * 2); rowA = R; colA2 = C * 2; }
    constexpr size_t rstep = (size_t)64 * ROWB;
    constexpr size_t kstep = (size_t)(BK * 2);
    constexpr size_t hstep = (size_t)HALF * ROWB;
    const unsigned ldsw = (unsigned)wid * 1024u;
    const int aoff = lds_byte(wr * 64 + fr, fq * 8), boff = lds_byte(wc * 32 + fr, fq * 8);
    LAS unsigned* TBL = (LAS unsigned*)(lds + L_TBL);
    constexpr unsigned TB2 = (unsigned)(L_GM + 2048 - L_TBL) / 4u; unsigned tn = 0u;
#define PG8_SA(b, h) (((b) * 2 + (h)) * HTB)
#define PG8_SB(b, h) ((4 + (b) * 2 + (h)) * HTB)
#define PG8_STAGE(bufoff, gbase, voff) do { _Pragma("unroll") for (int _i = 0; _i < 2; ++_i) \
        __builtin_amdgcn_global_load_lds((const GAS unsigned*)((const GAS char*)(gbase) + _i * rstep + (voff)), (LAS unsigned*)(lds + (bufoff) + ldsw + _i * 8192), 16, 0, 0); } while (0)
#define PG8_STAGE_G(bufoff, gbase, voff2) do { _Pragma("unroll") for (int _i = 0; _i < 2; ++_i) \
        __builtin_amdgcn_global_load_lds((const GAS unsigned*)((const GAS char*)(gbase) + (voff2)[_i]), (LAS unsigned*)(lds + (bufoff) + ldsw + _i * 8192), 16, 0, 0); } while (0)
#define PG8_STAGE_A(bufoff, ubase, h, gofs) do { if constexpr (GATHER) { PG8_STAGE_G(bufoff, ubase, (gofs)[h]); } else { PG8_STAGE(bufoff, (ubase) + (h) * hstep, voffA); } } while (0)
#define PG8_LDA(dst, b, h) do { _Pragma("unroll") for (int m = 0; m < 4; ++m) _Pragma("unroll") for (int k = 0; k < 2; ++k) dst[m][k] = *(const LAS bf16x8*)(lds + PG8_SA(b, h) + aoff + m * 2048 + k * 1024); } while (0)
#define PG8_LDB(dst, b, h) do { _Pragma("unroll") for (int n = 0; n < 2; ++n) _Pragma("unroll") for (int k = 0; k < 2; ++k) dst[n][k] = *(const LAS bf16x8*)(lds + PG8_SB(b, h) + boff + n * 2048 + k * 1024); } while (0)
#define PG8_MMA(ai, bj, At, Bt) do { __builtin_amdgcn_s_setprio(1); _Pragma("unroll") for (int m = 0; m < 4; ++m) _Pragma("unroll") for (int n = 0; n < 2; ++n) { \
        if constexpr (FP8) { const i32x8 b8 = __builtin_shufflevector(__builtin_bit_cast(i32x4, Bt[n][0]), __builtin_bit_cast(i32x4, Bt[n][1]), 0, 1, 2, 3, 4, 5, 6, 7), a8 = __builtin_shufflevector(__builtin_bit_cast(i32x4, At[m][0]), __builtin_bit_cast(i32x4, At[m][1]), 0, 1, 2, 3, 4, 5, 6, 7); \
            asm volatile("v_mfma_scale_f32_16x16x128_f8f6f4 %0, %1, %2, %0, %3, %4 op_sel_hi:[0,0,0]" : "+v"(acc[ai][bj][m][n]) : "v"(b8), "v"(a8), "v"(scB), "v"(scA)); } \
        else { _Pragma("unroll") for (int k = 0; k < 2; ++k) acc[ai][bj][m][n] = __builtin_amdgcn_mfma_f32_16x16x32_bf16(Bt[n][k], At[m][k], acc[ai][bj][m][n], 0, 0, 0); } } \
        __builtin_amdgcn_s_setprio(0); } while (0)
#define PG8_WAIT_V(n) asm volatile("s_waitcnt vmcnt(" #n ")" ::: "memory")
#define PG8_WAIT_L(n) asm volatile("s_waitcnt lgkmcnt(" #n ")" ::: "memory")
#define PG8_BAR __builtin_amdgcn_s_barrier()
#define PG8_SCHED __builtin_amdgcn_sched_barrier(0)
    int scA = Sched::SCALE_A, scB = Sched::SCALE_B; asm volatile("" : "+v"(scA), "+v"(scB));
    GUnit cur, nxt, nn; bool has_nn = false;
    if (!S.next(cur)) return;
    bool has_next = S.next(nxt);
    unsigned gcur[2][2] = {{0u, 0u}, {0u, 0u}};
    if constexpr (GATHER) {
        if (tid < 256) TBL[tid] = S.row_off(cur, tid);
        __syncthreads();
#pragma unroll
        for (int h = 0; h < 2; ++h)
#pragma unroll
            for (int i = 0; i < 2; ++i) gcur[h][i] = TBL[h * 128 + i * 64 + rowA] + (unsigned)colA2;
        __syncthreads();
        tn = TB2;
        if (has_next && tid < 256) TBL[tn + tid] = S.row_off(nxt, tid);
        if (has_next) has_nn = S.next(nn);
        __syncthreads();
    }
    f32x4 acc[2][2][4][2];
#pragma unroll
    for (int a = 0; a < 2; ++a)
#pragma unroll
        for (int b = 0; b < 2; ++b)
#pragma unroll
            for (int m = 0; m < 4; ++m)
#pragma unroll
                for (int n = 0; n < 2; ++n) acc[a][b][m][n] = (f32x4){0.f, 0.f, 0.f, 0.f};
    bf16x8 At[4][2], B0[2][2], B1[2][2];
    const GAS char* cA = S.a_ptr(cur); const GAS char* cB = S.b_ptr(cur);
    unsigned bpar = 0u;
#define PG8_BIAS_TO(unit, par) do { if (wid == 0) { const GAS float* bs_ = E.bias_src(unit, lane); if (bs_) __builtin_amdgcn_global_load_lds((const GAS unsigned*)bs_, (LAS unsigned*)(lds + L_GM + (par) * 1024u), 16, 0, 0); } } while (0)
#define PG8_BIAS(unit) PG8_BIAS_TO(unit, bpar)
    constexpr bool BINIT = Epi::BIAS_INIT;
    PG8_BIAS(cur);
    if constexpr (BINIT) { if (has_next) PG8_BIAS_TO(nxt, 1u); }
    PG8_STAGE(PG8_SB(0, 0), cB, voffB); PG8_STAGE(PG8_SB(0, 1), cB + hstep, voffB); PG8_STAGE_A(PG8_SA(0, 0), cA, 0, gcur); PG8_STAGE_A(PG8_SA(0, 1), cA, 1, gcur);
    if (wr == 1) PG8_BAR;
    PG8_WAIT_V(2); PG8_BAR;
    if constexpr (BINIT) { int tz = threadIdx.x; asm volatile("" : "+v"(tz)); E.init(acc, (const LAS float*)(lds + L_GM), wc, (tz & 63) >> 4); }
    PG8_STAGE(PG8_SB(1, 0), cB + kstep, voffB); PG8_STAGE_A(PG8_SA(1, 0), cA + kstep, 0, gcur); PG8_STAGE(PG8_SB(1, 1), cB + hstep + kstep, voffB);
    PG8_WAIT_V(6); PG8_BAR;
    for (;;) {
        const GAS char* nA = has_next ? S.a_ptr(nxt) : cA; const GAS char* nB = has_next ? S.b_ptr(nxt) : cB;
#pragma unroll 1
        for (int t = 0; t < nt; t += 2) {
            const bool last = (t == nt - 2);
            const GAS char* a1 = cA + (size_t)(t + 1) * kstep;
            const GAS char* a2 = last ? nA : cA + (size_t)(t + 2) * kstep; const GAS char* b2 = last ? nB : cB + (size_t)(t + 2) * kstep;
            const GAS char* a3 = a2 + kstep; const GAS char* b3 = b2 + kstep;
            unsigned g2[2][2];
            if constexpr (GATHER) {
#pragma unroll
                for (int h = 0; h < 2; ++h)
#pragma unroll
                    for (int i = 0; i < 2; ++i) g2[h][i] = gcur[h][i];
                if (last && has_next) {
#pragma unroll
                    for (int h = 0; h < 2; ++h)
#pragma unroll
                        for (int i = 0; i < 2; ++i) g2[h][i] = TBL[tn + h * 128 + i * 64 + rowA] + (unsigned)colA2;
                }
            }
            PG8_LDB(B0, 0, 0); PG8_LDB(B1, 0, 1); PG8_SCHED; PG8_LDA(At, 0, 0); PG8_STAGE_A(PG8_SA(1, 1), a1, 1, gcur);
            PG8_WAIT_V(8); PG8_WAIT_L(0); PG8_BAR; PG8_MMA(0, 0, At, B0); PG8_MMA(0, 1, At, B1); PG8_BAR; PG8_SCHED;
            PG8_LDA(At, 0, 1); PG8_STAGE(PG8_SB(0, 0), b2, voffB); PG8_STAGE(PG8_SB(0, 1), b2 + hstep, voffB); PG8_STAGE_A(PG8_SA(0, 0), a2, 0, g2);
            PG8_WAIT_V(8); PG8_WAIT_L(0); PG8_BAR; PG8_MMA(1, 0, At, B0); PG8_MMA(1, 1, At, B1); PG8_BAR; PG8_SCHED;
            PG8_LDB(B0, 1, 0); PG8_LDB(B1, 1, 1); PG8_SCHED; PG8_LDA(At, 1, 0); PG8_STAGE_A(PG8_SA(0, 1), a2, 1, g2);
            PG8_WAIT_V(8); PG8_WAIT_L(0); PG8_BAR; PG8_MMA(0, 0, At, B0); PG8_MMA(0, 1, At, B1); PG8_BAR; PG8_SCHED;
            PG8_LDA(At, 1, 1); PG8_STAGE(PG8_SB(1, 0), b3, voffB); PG8_STAGE(PG8_SB(1, 1), b3 + hstep, voffB); PG8_STAGE_A(PG8_SA(1, 0), a3, 0, g2);
            PG8_WAIT_V(8); PG8_WAIT_L(0); PG8_BAR; PG8_MMA(1, 0, At, B0); PG8_MMA(1, 1, At, B1); PG8_BAR; PG8_SCHED;
        }
        if (wr == 0) PG8_BAR;
        unsigned pre_off = 0u;
        if constexpr (GATHER) { if (has_next && has_nn && tid < 256) pre_off = S.row_off(nn, tid); }
        if constexpr (FP8) asm volatile("s_nop 15\n\ts_nop 15" ::: "memory");
        { int tz = threadIdx.x; asm volatile("" : "+v"(tz)); const int ln2 = tz & 63; E(acc, cur, wr, wc, ln2 & 15, ln2 >> 4, (const LAS float*)(lds + L_GM + bpar * 1024u)); }
        if (!has_next) break;
#pragma unroll
        for (int a = 0; a < 2; ++a)
#pragma unroll
            for (int b = 0; b < 2; ++b)
#pragma unroll
                for (int m = 0; m < 4; ++m)
#pragma unroll
                    for (int n = 0; n < 2; ++n) acc[a][b][m][n] = (f32x4){0.f, 0.f, 0.f, 0.f};
        cur = nxt; cA = nA; cB = nB;
        bpar ^= 1u;
        if constexpr (BINIT) { int tz = threadIdx.x; asm volatile("" : "+v"(tz)); E.init(acc, (const LAS float*)(lds + L_GM + bpar * 1024u), wc, (tz & 63) >> 4); }
        else PG8_BIAS(cur);
        if constexpr (GATHER) {
#pragma unroll
            for (int h = 0; h < 2; ++h)
#pragma unroll
                for (int i = 0; i < 2; ++i) gcur[h][i] = TBL[tn + h * 128 + i * 64 + rowA] + (unsigned)colA2;
            tn ^= TB2;
            has_next = has_nn;
            if (has_next) { nxt = nn; if (tid < 256) TBL[tn + tid] = pre_off; has_nn = S.next(nn); }
        } else {
            has_next = S.next(nxt);
        }
        if constexpr (BINIT) { if (has_next) PG8_BIAS_TO(nxt, bpar ^ 1u); }
        if (wr == 1) PG8_BAR;
    }
    PG8_WAIT_V(0);
    PG8_BAR;
#undef PG8_SA
#undef PG8_SB
#undef PG8_STAGE
#undef PG8_STAGE_A
#undef PG8_STAGE_G
#undef PG8_LDA
#undef PG8_LDB
#undef PG8_MMA
#undef PG8_WAIT_V
#undef PG8_WAIT_L
#undef PG8_BAR
#undef PG8_SCHED
#undef PG8_BIAS
#undef PG8_BIAS_TO
}

template <bool FP8_>
struct DenseSchedT {
    static constexpr bool GATHER = false, FP8 = FP8_; static constexpr int SCALE_A = 0x7f7f7f7f, SCALE_B = FP8_ ? 0x7a7a7a7a : 0x7f7f7f7f;
    static constexpr int ROWB = FP8_ ? GK : GK * 2;
    const GAS char* A; const GAS char* Bt; int nM, nN, nwg, G, c, i;
    DI void init(const GAS void* A_, const GAS void* Bt_, int M, int N, int G_, int c_) { A = (const GAS char*)A_; Bt = (const GAS char*)Bt_; nM = M / BM; nN = N / BM; nwg = nM * nN; G = G_; c = c_; i = 0; }
    DI bool next(GUnit& u) {
        const long L = (long)i * G + c; ++i; if (L >= nwg) return false;
        int wgid = (int)L; { const int q = nwg / 8, r = nwg % 8, xcd = wgid % 8, off = wgid / 8; wgid = (xcd < r ? xcd * (q + 1) : r * (q + 1) + (xcd - r) * q) + off; }
        const int nig = 8 * nN, gid = wgid / nig, fm = gid * 8, gsz = (nM - fm) < 8 ? (nM - fm) : 8;
        const int pm = fm + ((wgid % nig) % gsz); u.pn = (wgid % nig) / gsz; u.row0 = pm * BM; u.e = 0; u.aux = 0; return true;
    }
    DI const GAS char* a_ptr(const GUnit& u) const { return A + (size_t)u.row0 * ROWB; }
    DI const GAS char* b_ptr(const GUnit& u) const { return Bt + (size_t)u.pn * (BM * ROWB); }
    DI unsigned row_off(const GUnit&, int) const { return 0u; }
};

typedef DenseSchedT<false> DenseSched;
typedef DenseSchedT<true> DenseSched8;
#ifndef G1_FP8_FROM
#define G1_FP8_FROM 0
#endif
template <bool GATHER_, int NCT, int NB  >
struct MoeSched {
    static constexpr bool GATHER = GATHER_, FP8 = true; static constexpr int SCALE_A = 0x7f7f7f7f, SCALE_B = 0x7a7a7a7a;
    static constexpr int ROWB = GK;
    const GAS char* A; const GAS char* Bt; const GAS int* slot_tok; LAS unsigned char* lds; int G, c, i, nrt, ltot;
    DI void init(const GAS void* A_, const GAS void* Bt_, const GAS int* st, LAS unsigned char* lds_, int G_, int c_) {
        A = (const GAS char*)A_; Bt = (const GAS char*)Bt_; slot_tok = st; lds = lds_; G = G_; c = c_; i = 0;
        nrt = __builtin_amdgcn_readfirstlane(((LAS int*)(lds + L_TPRE))[32]); ltot = ((nrt + 7) / 8) * 8 * NCT;
    }
    DI bool next(GUnit& u) {
        for (;;) {
            const int L = i * G + c; ++i; if (L >= ltot) return false;
            const int q = L / (8 * NCT), r = L % (8 * NCT), rt = q * 8 + (r & 7), ct = r >> 3;
            if (rt >= nrt) continue;
            const int e = __builtin_amdgcn_readfirstlane((int)((LAS unsigned char*)(lds + L_RT2E))[rt]);
            const int tp = __builtin_amdgcn_readfirstlane(((LAS int*)(lds + L_TPRE))[e]);
            u.row0 = rt * 256; u.pn = ct; u.e = e; u.aux = rt - tp; return true;
        }
    }
    DI const GAS char* a_ptr(const GUnit& u) const { return GATHER ? A : A + (size_t)u.row0 * ROWB; }
    DI const GAS char* b_ptr(const GUnit& u) const { return Bt + ((size_t)u.e * NB + (size_t)u.pn * BM) * ROWB; }
    DI unsigned row_off(const GUnit& u, int r) const {
        const int cnt = ((LAS int*)(lds + L_CNT))[u.e]; const int pos = u.aux * 256 + r;
        const int tok = pos < cnt ? slot_tok[(size_t)u.e * ECAP + pos] : 0;
        return (unsigned)tok * (unsigned)ROWB;
    }
};

struct EpiProj {
    static constexpr bool PERM = true; static constexpr bool BIAS_INIT = false;
    GAS bf16_t* O;
    DI const GAS float* bias_src(const GUnit&, int) const { return nullptr; }
    DI void operator()(const f32x4 (&acc)[2][2][4][2], const GUnit& u, int wr, int wc, int fr, int fq, const LAS float*) const {
        const int row0 = u.row0 + wr * 64 + fr, col0 = u.pn * BM + wc * 32 + 8 * fq;
        const int act = u.pn >= 10 ? 2 : 0;
#pragma unroll
        for (int ai = 0; ai < 2; ++ai)
#pragma unroll
            for (int m = 0; m < 4; ++m) { GAS bf16_t* rowp = O + (size_t)(row0 + ai * HALF + m * 16) * INC + col0;
#pragma unroll
                for (int bj = 0; bj < 2; ++bj) { f32x4 v0 = acc[ai][bj][m][0], v1 = acc[ai][bj][m][1];
                    if (act == 1) {
#pragma unroll
                        for (int j = 0; j < 4; ++j) { v0[j] = gelu_tanh(v0[j]); v1[j] = gelu_tanh(v1[j]); } }
                    else if (act == 2) {
#pragma unroll
                        for (int j = 0; j < 4; ++j) { v0[j] = silu_f(v0[j]); v1[j] = silu_f(v1[j]); } }
                    u32x4 w; w.x = pk2(v0[0], v0[1]); w.y = pk2(v0[2], v0[3]); w.z = pk2(v1[0], v1[1]); w.w = pk2(v1[2], v1[3]);
                    *(GAS u32x4*)(rowp + bj * HALF) = w; } }
    }
};
#define SCHEDB_E() __builtin_amdgcn_sched_barrier(0)
struct EpiResid {
    static constexpr bool PERM = true; static constexpr bool BIAS_INIT = false;
    const GAS float* xin32; const GAS bf16_t* xin16; GAS bf16_t* xout; const GAS float* gate;
    DI const GAS float* bias_src(const GUnit& u, int lane) const { return gate + (size_t)(u.row0 / SEQ) * (NMOD * D) + u.pn * BM + 4 * lane; }
    DI void operator()(const f32x4 (&acc)[2][2][4][2], const GUnit& u, int wr, int wc, int fr, int fq, const LAS float* BL) const {
        const int row0 = u.row0 + wr * 64 + fr, col0 = u.pn * BM + wc * 32 + 8 * fq;
        f32x4 gv[2][2];
#pragma unroll
        for (int bj = 0; bj < 2; ++bj)
#pragma unroll
            for (int n = 0; n < 2; ++n) gv[bj][n] = *(const LAS f32x4*)(BL + wc * 32 + 8 * fq + bj * HALF + 4 * n);
        if (xin32) {
#pragma unroll
            for (int ai = 0; ai < 2; ++ai)
#pragma unroll
            for (int mh = 0; mh < 2; ++mh) { f32x4 xa[2][2][2];
#pragma unroll
                for (int mm = 0; mm < 2; ++mm) { const size_t off = (size_t)(row0 + ai * HALF + (2 * mh + mm) * 16) * D + col0;
#pragma unroll
                    for (int bj = 0; bj < 2; ++bj) { xa[mm][bj][0] = *(const GAS f32x4*)(xin32 + off + bj * HALF); xa[mm][bj][1] = *(const GAS f32x4*)(xin32 + off + bj * HALF + 4); } }
                SCHEDB_E();
#pragma unroll
                for (int mm = 0; mm < 2; ++mm) { const int m = 2 * mh + mm; const size_t off = (size_t)(row0 + ai * HALF + m * 16) * D + col0;
#pragma unroll
                    for (int bj = 0; bj < 2; ++bj) { const f32x4 v0 = xa[mm][bj][0] + gv[bj][0] * acc[ai][bj][m][0], v1 = xa[mm][bj][1] + gv[bj][1] * acc[ai][bj][m][1];
                        u32x4 w; w.x = pk2(v0[0], v0[1]); w.y = pk2(v0[2], v0[3]); w.z = pk2(v1[0], v1[1]); w.w = pk2(v1[2], v1[3]);
                        *(GAS u32x4*)(xout + off + bj * HALF) = w; } } }
        } else {
#pragma unroll
            for (int ai = 0; ai < 2; ++ai) { u32x4 xr[4][2];
#pragma unroll
                for (int m = 0; m < 4; ++m) { const size_t off = (size_t)(row0 + ai * HALF + m * 16) * D + col0;
#pragma unroll
                    for (int bj = 0; bj < 2; ++bj) xr[m][bj] = *(const GAS u32x4*)(xin16 + off + bj * HALF); }
                SCHEDB_E();
#pragma unroll
                for (int m = 0; m < 4; ++m) { const size_t off = (size_t)(row0 + ai * HALF + m * 16) * D + col0;
#pragma unroll
                    for (int bj = 0; bj < 2; ++bj) { const u32x4 q = xr[m][bj];
                        const f32x4 x0 = (f32x4){bflo(q.x), bfhi(q.x), bflo(q.y), bfhi(q.y)}, x1 = (f32x4){bflo(q.z), bfhi(q.z), bflo(q.w), bfhi(q.w)};
                        const f32x4 v0 = x0 + gv[bj][0] * acc[ai][bj][m][0], v1 = x1 + gv[bj][1] * acc[ai][bj][m][1];
                        u32x4 w; w.x = pk2(v0[0], v0[1]); w.y = pk2(v0[2], v0[3]); w.z = pk2(v1[0], v1[1]); w.w = pk2(v1[2], v1[3]);
                        *(GAS u32x4*)(xout + off + bj * HALF) = w; } } }
        }
    }
};
struct EpiSwiglu {
    static constexpr bool PERM = false; static constexpr bool BIAS_INIT = true;
    DI void init(f32x4 (&acc)[2][2][4][2], const LAS float* BL, int wc, int fq) const {
#pragma unroll
        for (int bj = 0; bj < 2; ++bj) { const f32x4 bg = *(const LAS f32x4*)(BL + wc * 32 + 8 * fq + 4 * bj), bl = *(const LAS f32x4*)(BL + 128 + wc * 32 + 8 * fq + 4 * bj);
#pragma unroll
            for (int ai = 0; ai < 2; ++ai)
#pragma unroll
                for (int m = 0; m < 4; ++m) { acc[ai][bj][m][0] = bg; acc[ai][bj][m][1] = bl; } }
    }
    GAS unsigned char* O; const GAS float* b1;
    DI const GAS float* bias_src(const GUnit& u, int lane) const { return b1 + (size_t)u.e * (2 * FF) + (lane >> 5) * FF + u.pn * 128 + 4 * (lane & 31); }
    DI void operator()(const f32x4 (&acc)[2][2][4][2], const GUnit& u, int wr, int wc, int fr, int fq, const LAS float* BL) const {
        const int row0 = u.row0 + wr * 64 + fr, ocol = u.pn * 128 + wc * 32 + 8 * fq;
#pragma unroll
        for (int ai = 0; ai < 2; ++ai)
#pragma unroll
            for (int m = 0; m < 4; ++m) { GAS unsigned char* rowp = O + (size_t)(row0 + ai * HALF + m * 16) * FF + ocol;
                f32x4 o[2];
#pragma unroll
                for (int bj = 0; bj < 2; ++bj) { f32x4 g = acc[ai][bj][m][0], l = acc[ai][bj][m][1];
#pragma unroll
                    for (int j = 0; j < 4; ++j) { g[j] = fminf(g[j], 7.0f); l[j] = __builtin_amdgcn_fmed3f(l[j], -7.0f, 7.0f); }
                    f32x4 e = g * (-1.702f * 1.4426950408889634f);
#pragma unroll
                    for (int j = 0; j < 4; ++j) e[j] = __builtin_amdgcn_exp2f(e[j]);
                    e = e + 1.0f;
#pragma unroll
                    for (int j = 0; j < 4; ++j) e[j] = __builtin_amdgcn_rcpf(e[j]);
                    const f32x4 p = g * e; o[bj] = p * l + p; }
                u32x2 w; w.x = pk4_fp8(o[0][0], o[0][1], o[0][2], o[0][3]); w.y = pk4_fp8(o[1][0], o[1][1], o[1][2], o[1][3]);
                *(GAS u32x2*)rowp = w; }
    }
};
struct EpiY {
    static constexpr bool PERM = false; static constexpr bool BIAS_INIT = true;
    DI void init(f32x4 (&acc)[2][2][4][2], const LAS float* BL, int wc, int fq) const {
#pragma unroll
        for (int bj = 0; bj < 2; ++bj)
#pragma unroll
            for (int n = 0; n < 2; ++n) { const f32x4 bv = *(const LAS f32x4*)(BL + wc * 64 + 16 * fq + 8 * bj + 4 * n);
#pragma unroll
                for (int ai = 0; ai < 2; ++ai)
#pragma unroll
                    for (int m = 0; m < 4; ++m) acc[ai][bj][m][n] = bv; }
    }
    GAS unsigned char* O; const GAS float* b2;
    DI const GAS float* bias_src(const GUnit& u, int lane) const { return b2 + (size_t)u.e * D + u.pn * BM + 4 * lane; }
    DI void operator()(const f32x4 (&acc)[2][2][4][2], const GUnit& u, int wr, int wc, int fr, int fq, const LAS float* BL) const {
        const int row0 = u.row0 + wr * 64 + fr, col0 = u.pn * BM + wc * 64 + 16 * fq;
#pragma unroll
        for (int ai = 0; ai < 2; ++ai)
#pragma unroll
            for (int m = 0; m < 4; ++m) { GAS unsigned char* rowp = O + (size_t)(row0 + ai * HALF + m * 16) * D + col0;
                unsigned w4[4];
#pragma unroll
                for (int bj = 0; bj < 2; ++bj)
#pragma unroll
                    for (int n = 0; n < 2; ++n) { const f32x4 v = acc[ai][bj][m][n]; w4[2 * bj + n] = pk4_fp8(clamp8(v[0]), clamp8(v[1]), clamp8(v[2]), clamp8(v[3])); }
                *(GAS u32x4*)rowp = (u32x4){w4[0], w4[1], w4[2], w4[3]}; }
    }
};

DI void p0_mod(const Frame& F0) {
    Frame F = F0; F.ws = launder_s(F0.ws); F.in = launder_s(F0.in); { int t_ = F0.tid; asm volatile("" : "+v"(t_)); F.tid = t_; F.lane = t_ & 63; int c_ = __builtin_amdgcn_readfirstlane(F0.c); asm volatile("" : "+s"(c_)); F.c = c_; }
    const GAS float* c = F.in[I_C]; const GAS float* wada = F.in[I_WADA]; const GAS float* bada = F.in[I_BADA];
    GAS float* mod = (GAS float*)(F.ws + WS_MOD);
    LAS float* ca = (LAS float*)F.lds;
    for (int it = F.c; it < DEPTH * 12 * 4; it += F.G) {
        const int l = it / 48, r = it % 48, jb = r / 4, bg = r % 4;
        __syncthreads();
        for (int u = F.tid; u < 8 * 1024; u += NTHR) { const int bb = u >> 10, i = u & 1023; ca[i * 8 + bb] = silu_f(c[(size_t)(bg * 8 + bb) * D + i]); }
        __syncthreads();
        const int q = F.tid >> 7, cg = F.tid & 127;
        const GAS float* wp = wada + (size_t)l * D * (NMOD * D) + jb * 512 + 4 * cg;
        f32x4 a[8];
#pragma unroll
        for (int bb = 0; bb < 8; ++bb) a[bb] = (f32x4){0.f, 0.f, 0.f, 0.f};
#pragma unroll 8
        for (int i = 256 * q; i < 256 * q + 256; ++i) { const f32x4 w = *(const GAS f32x4*)(wp + (size_t)i * (NMOD * D)); const f32x4 c0 = *(const LAS f32x4*)(ca + i * 8), c1 = *(const LAS f32x4*)(ca + i * 8 + 4);
            a[0] += w * c0[0]; a[1] += w * c0[1]; a[2] += w * c0[2]; a[3] += w * c0[3]; a[4] += w * c1[0]; a[5] += w * c1[1]; a[6] += w * c1[2]; a[7] += w * c1[3]; }
        LAS float* red = (LAS float*)(F.lds + 32768);
#pragma unroll
        for (int bb = 0; bb < 8; ++bb) *(LAS f32x4*)(red + (q * 8 + bb) * 512 + 4 * cg) = a[bb];
        __syncthreads();
        const int j = jb * 512 + F.tid;
        const float bj = bada[(size_t)l * (NMOD * D) + j];
#pragma unroll
        for (int bb = 0; bb < 8; ++bb) { const float s = (red[(0 * 8 + bb) * 512 + F.tid] + red[(1 * 8 + bb) * 512 + F.tid]) + (red[(2 * 8 + bb) * 512 + F.tid] + red[(3 * 8 + bb) * 512 + F.tid]);
            mod[((size_t)l * BATCH + bg * 8 + bb) * (NMOD * D) + j] = s + bj; }
    }
    __syncthreads();
}
DI void p0_tables(const Frame& F0) {
    Frame F = F0; F.ws = launder_s(F0.ws); F.in = launder_s(F0.in); { int t_ = F0.tid; asm volatile("" : "+v"(t_)); F.tid = t_; F.lane = t_ & 63; int c_ = __builtin_amdgcn_readfirstlane(F0.c); asm volatile("" : "+s"(c_)); F.c = c_; }
    const int gt = F.c * NTHR + F.tid, NGT = F.G * NTHR;
    const GAS float* wsp = F.in[I_WSP]; GAS bf16_t* wst = (GAS bf16_t*)(F.ws + WS_WST);
    for (int u = gt; u < DEPTH * 4 * 128 * 128; u += NGT) { const int s = u & 127, t = (u >> 7) & 127; wst[u] = (bf16_t)(s <= t ? f2bf(wsp[u]) : 0u); }
    const GAS float* wr = F.in[I_WR]; GAS bf16_t* wri = (GAS bf16_t*)(F.ws + WS_WRT);
    for (int u = gt; u < DEPTH * NE * D; u += NGT) { const int i = u & 1023, e = (u >> 10) & 31, ll = u >> 15; const float w = wr[((size_t)ll * D + i) * NE + e];
        const unsigned hi = f2bf(w); const unsigned lo = f2bf(w - __builtin_bit_cast(float, hi << 16));
        GAS bf16_t* img = wri + (size_t)ll * (WRI_BYTES / 2); img[e * (WRI_ROWB / 2) + i] = (bf16_t)hi; img[32 * (WRI_ROWB / 2) + e * (WRI_ROWB / 2) + i] = (bf16_t)lo; }
}
template <int MODE  >
DI void transpose_item(const GAS float* W, int N, GAS bf16_t* WT, LAS float* scr, int item, int lane) {
    constexpr int K = 1024;
    const int nblk = N / 32, kb = item / nblk, nb = item % nblk, k0 = 64 * kb, n0 = 32 * nb;
    const int c4 = lane & 7, kr = lane >> 3;
    f32x4 v[8];
#pragma unroll
    for (int i = 0; i < 8; ++i) v[i] = __builtin_nontemporal_load((const GAS f32x4*)(W + (size_t)(k0 + kr + 8 * i) * N + n0 + 4 * c4));
#pragma unroll
    for (int i = 0; i < 8; ++i) { LAS float* d = scr + (kr + 8 * i) * 33 + 4 * c4; d[0] = v[i].x; d[1] = v[i].y; d[2] = v[i].z; d[3] = v[i].w; }
    asm volatile("s_waitcnt lgkmcnt(0)" ::: "memory");
    const int cc = lane & 7;
#pragma unroll
    for (int j = 0; j < 4; ++j) { const int n = (lane >> 3) + 8 * j; const LAS float* s = scr + (8 * cc) * 33 + n;
        u32x4 o; o.x = pk2(s[0 * 33], s[1 * 33]); o.y = pk2(s[2 * 33], s[3 * 33]); o.z = pk2(s[4 * 33], s[5 * 33]); o.w = pk2(s[6 * 33], s[7 * 33]);
        int dr = n0 + n;
        if (MODE == 1) { const int sc = dr, nn = sc >> 10, g = sc & 1023, pn = g >> 7, wc = (g >> 5) & 3, fq = (g >> 3) & 3, bj = (g >> 2) & 1, jj = g & 3;
            dr = 256 * pn + 128 * bj + 32 * wc + 16 * nn + 4 * fq + jj; }
        *(GAS u32x4*)(WT + (size_t)dr * K + k0 + 8 * cc) = o; }
    asm volatile("s_waitcnt lgkmcnt(0)" ::: "memory");
}
template <int MODE>
DI void transpose_item8(const GAS float* W, int N, GAS unsigned char* WT, LAS float* scr, int item, int lane) {
    constexpr int K = 1024;
    const int nblk = N / 32, kb = item / nblk, nb = item % nblk, k0 = 64 * kb, n0 = 32 * nb;
    const int c4 = lane & 7, kr = lane >> 3;
    f32x4 v[8];
#pragma unroll
    for (int i = 0; i < 8; ++i) v[i] = __builtin_nontemporal_load((const GAS f32x4*)(W + (size_t)(k0 + kr + 8 * i) * N + n0 + 4 * c4));
#pragma unroll
    for (int i = 0; i < 8; ++i) { LAS float* d = scr + (kr + 8 * i) * 33 + 4 * c4; d[0] = v[i].x; d[1] = v[i].y; d[2] = v[i].z; d[3] = v[i].w; }
    asm volatile("s_waitcnt lgkmcnt(0)" ::: "memory");
    const int kq = lane & 3;
#pragma unroll
    for (int j = 0; j < 2; ++j) { const int n = (lane >> 2) + 16 * j; const LAS float* s = scr + (16 * kq) * 33 + n;
        float f[16];
#pragma unroll
        for (int e = 0; e < 16; ++e) f[e] = clamp8(s[e * 33] * 32.0f);
        u32x4 o; o.x = pk4_fp8(f[0], f[1], f[2], f[3]); o.y = pk4_fp8(f[4], f[5], f[6], f[7]); o.z = pk4_fp8(f[8], f[9], f[10], f[11]); o.w = pk4_fp8(f[12], f[13], f[14], f[15]);
        int dr = n0 + n;
        if (MODE == 1) { const int sc = dr, nn = sc >> 10, g = sc & 1023, pn = g >> 7, wc = (g >> 5) & 3, fq = (g >> 3) & 3, bj = (g >> 2) & 1, jj = g & 3;
            dr = 256 * pn + 128 * bj + 32 * wc + 16 * nn + 4 * fq + jj; }
        if (MODE == 2) { const int sc = dr, c = sc & 255, wc = c >> 6, fq = (c >> 4) & 3, bj = (c >> 3) & 1, nn = (c >> 2) & 1, jj = c & 3;
            dr = (sc & ~255) + 128 * bj + 32 * wc + 16 * nn + 4 * fq + jj; }
        __builtin_nontemporal_store(o, (GAS u32x4*)(WT + (size_t)dr * K + k0 + 16 * kq)); }
    asm volatile("s_waitcnt lgkmcnt(0)" ::: "memory");
}
template <int MODE>
DI void transpose_item8w(const GAS float* W, int N, GAS unsigned char* WT, LAS float* scr, int item, int lane) {
    constexpr int K = 1024;
    const int nblk = N / 32, kb = item / nblk, nb = item % nblk, k0 = 128 * kb, n0 = 32 * nb;
    const int c4 = lane & 7, kr = lane >> 3;
    f32x4 v[16];
#pragma unroll
    for (int i = 0; i < 16; ++i) v[i] = __builtin_nontemporal_load((const GAS f32x4*)(W + (size_t)(k0 + kr + 8 * i) * N + n0 + 4 * c4));
#pragma unroll
    for (int i = 0; i < 16; ++i) { LAS float* d = scr + (kr + 8 * i) * 33 + 4 * c4; d[0] = v[i].x; d[1] = v[i].y; d[2] = v[i].z; d[3] = v[i].w; }
    asm volatile("s_waitcnt lgkmcnt(0)" ::: "memory");
    const int kq = lane & 7;
#pragma unroll
    for (int j = 0; j < 4; ++j) { const int n = (lane >> 3) + 8 * j; const LAS float* s = scr + (16 * kq) * 33 + n;
        float f[16];
#pragma unroll
        for (int e = 0; e < 16; ++e) f[e] = clamp8(s[e * 33] * 32.0f);
        u32x4 o; o.x = pk4_fp8(f[0], f[1], f[2], f[3]); o.y = pk4_fp8(f[4], f[5], f[6], f[7]); o.z = pk4_fp8(f[8], f[9], f[10], f[11]); o.w = pk4_fp8(f[12], f[13], f[14], f[15]);
        int dr = n0 + n;
        if (MODE == 1) { const int sc = dr, nn = sc >> 10, g = sc & 1023, pn = g >> 7, wc = (g >> 5) & 3, fq = (g >> 3) & 3, bj = (g >> 2) & 1, jj = g & 3;
            dr = 256 * pn + 128 * bj + 32 * wc + 16 * nn + 4 * fq + jj; }
        if (MODE == 2) { const int sc = dr, c = sc & 255, wc = c >> 6, fq = (c >> 4) & 3, bj = (c >> 3) & 1, nn = (c >> 2) & 1, jj = c & 3;
            dr = (sc & ~255) + 128 * bj + 32 * wc + 16 * nn + 4 * fq + jj; }
        __builtin_nontemporal_store(o, (GAS u32x4*)(WT + (size_t)dr * K + k0 + 16 * kq)); }
    asm volatile("s_waitcnt lgkmcnt(0)" ::: "memory");
}
#define SCHEDB_() __builtin_amdgcn_sched_barrier(0)
template <bool H8>
DI void modnorm_rows(const Frame& F, const GAS float* xsrc, GAS bf16_t* hdst, int row_first, int nrows  , const GAS float* g, const GAS float* sc, const GAS float* sh) {
    f32x4 gm[4], sv[4];
#pragma unroll
    for (int j = 0; j < 4; ++j) { const f32x4 gg = *(const GAS f32x4*)(g + 4 * F.lane + 256 * j), ss = *(const GAS f32x4*)(sc + 4 * F.lane + 256 * j); gm[j] = gg * (ss + 1.0f); sv[j] = *(const GAS f32x4*)(sh + 4 * F.lane + 256 * j); }
    auto ld = [&](f32x4 (&v)[4], size_t row) {
#pragma unroll
        for (int j = 0; j < 4; ++j) v[j] = __builtin_nontemporal_load((const GAS f32x4*)(xsrc + row * D) + F.lane + 64 * j); };
    auto put = [&](const f32x4 (&v)[4], size_t row) {
        float s = 0.f;
#pragma unroll
        for (int j = 0; j < 4; ++j) s += (v[j].x * v[j].x + v[j].y * v[j].y) + (v[j].z * v[j].z + v[j].w * v[j].w);
        const float rstd = 1.0f / sqrtf(wave_sum(s) * (1.f / D) + EPS);
        GAS u32x2* o8 = (GAS u32x2*)(hdst + row * D) + F.lane; GAS unsigned* o4 = (GAS unsigned*)((GAS unsigned char*)hdst + row * D) + F.lane;
#pragma unroll
        for (int j = 0; j < 4; ++j) { const f32x4 h = v[j] * rstd * gm[j] + sv[j];
            if (H8) o4[64 * j] = pk4_fp8(clamp8(h.x), clamp8(h.y), clamp8(h.z), clamp8(h.w));
            else { u32x2 w; w.x = pk2(h.x, h.y); w.y = pk2(h.z, h.w); o8[64 * j] = w; } } };
    f32x4 va[4], vb[4];
    ld(va, (size_t)row_first);
    for (int r = 0; r < nrows; r += 2) {
        const size_t row = (size_t)(row_first + r);
        ld(vb, row + 1); SCHEDB_();
        put(va, row);
        ld(va, r + 2 < nrows ? row + 2 : row); SCHEDB_();
        put(vb, row + 1);
    }
}
DI void p1_prologue(const Frame& F0) {
    Frame F = F0; F.ws = launder_s(F0.ws); F.in = launder_s(F0.in); { int t_ = F0.tid; asm volatile("" : "+v"(t_)); F.tid = t_; F.lane = t_ & 63; int c_ = __builtin_amdgcn_readfirstlane(F0.c); asm volatile("" : "+s"(c_)); F.c = c_; }
    LAS float* scr = (LAS float*)(F.lds + (F.wave < 7 ? F.wave * 16896 : L_TINFO));
    const int gw = F.c * NWAVES + F.wave, NGW = F.G * NWAVES;
    const GAS float* win = F.in[I_WIN]; const GAS float* wout = F.in[I_WOUT]; const GAS float* w1 = F.in[I_W1]; const GAS float* w2 = F.in[I_W2];
    GAS bf16_t* win_t = (GAS bf16_t*)(F.ws + WS_WIN); GAS bf16_t* wout_t = (GAS bf16_t*)(F.ws + WS_WOUT); GAS bf16_t* w1_t = (GAS bf16_t*)(F.ws + WS_W1); GAS bf16_t* w2_t = (GAS bf16_t*)(F.ws + WS_W2);
    for (int it = gw; it < DEPTH * 16 * 96; it += NGW) { const int mat = it / 1536, r = it % 1536;
        if (mat >= G1_FP8_FROM) transpose_item8<0>(win + (size_t)mat * D * INC, INC, (GAS unsigned char*)(win_t + (size_t)mat * INC * D), scr, r, F.lane);
        else transpose_item<0>(win + (size_t)mat * D * INC, INC, win_t + (size_t)mat * INC * D, scr, r, F.lane); }
    for (int it = gw; it < DEPTH * 16 * 32; it += NGW) { const int mat = it / 512, r = it % 512; transpose_item<0>(wout + (size_t)mat * D * D, D, wout_t + (size_t)mat * D * D, scr, r, F.lane); }
    for (int it = gw; it < DEPTH * NE * 8 * 64; it += NGW) { const int mat = it / 512, r = it % 512; transpose_item8w<1>(w1 + (size_t)mat * D * 2 * FF, 2 * FF, (GAS unsigned char*)w1_t + (size_t)mat * 2 * FF * D, scr, r, F.lane); }
    for (int it = gw; it < DEPTH * NE * 8 * 32; it += NGW) { const int mat = it / 256, r = it % 256; transpose_item8w<2>(w2 + (size_t)mat * FF * D, D, (GAS unsigned char*)w2_t + (size_t)mat * D * FF, scr, r, F.lane); }
    const GAS float* mod = (const GAS float*)(F.ws + WS_MOD);
    for (int blk = gw; blk < T / 32; blk += NGW) { const int row0 = blk * 32, b = row0 / SEQ; const GAS float* mb = mod + (size_t)b * (NMOD * D);
        modnorm_rows<(0 >= G1_FP8_FROM)>(F, F.in[I_X], (GAS bf16_t*)(F.ws + WS_H), row0, 32, F.in[I_GMIX], mb + 1 * D, mb + 0 * D); }
}

DI unsigned img_off(unsigned row, unsigned ch) { return 256u * row + 16u * (ch ^ (((row & 3u) << 2) | ((row >> 2) & 3u))); }
DI s16x4 tr4(LAS unsigned char* img, unsigned rowg, unsigned cb, unsigned q, unsigned p) {
    return __builtin_amdgcn_ds_read_tr16_b64_v4i16((LAS s16x4*)(img + img_off(rowg + q, 2u * cb + (p >> 1)) + 8u * (p & 1u)));
}
DI bf16x8 cat8(s16x4 lo, s16x4 hi) { return __builtin_shufflevector(lo, hi, 0, 1, 2, 3, 4, 5, 6, 7); }
#define MFMA16(a, b, c) __builtin_amdgcn_mfma_f32_16x16x32_bf16((a), (b), (c), 0, 0, 0)

struct MixLane { unsigned rbase, trA0, trA1, trB, wbase; };
DI MixLane mix_lane(int lane, int w) {
    const unsigned fr = lane & 15, fq = lane >> 4, q = fr >> 2, p = fr & 3;
    MixLane L;
    L.rbase = 256u * fr + 64u * (fr & 3u) + 16u * (fq ^ ((fr >> 2) & 3u));
    const unsigned XA = (q << 1) | (fq & 1u);
    L.trA0 = 2048u * fq + 256u * q + 32u * XA + 16u * (p >> 1) + 8u * (p & 1u);
    L.trA1 = 2048u * fq + 1024u + 256u * q + 32u * XA + 16u * ((p >> 1) ^ 1u) + 8u * (p & 1u);
    const unsigned XB = (q << 1) | (fq >> 1);
    L.trB = 1024u * fq + 256u * q + 32u * XB + 16u * ((p >> 1) ^ (fq & 1u)) + 8u * (p & 1u);
    const unsigned XW = ((fr & 3u) << 1) | ((fr >> 3) & 1u);
    L.wbase = 4096u * (unsigned)w + 256u * fr + 32u * XW + 16u * ((fq >> 1) ^ ((fr >> 2) & 1u)) + 8u * (fq & 1u);
    return L;
}
DI s16x4 trr(LAS unsigned char* img, unsigned a) { return __builtin_amdgcn_ds_read_tr16_b64_v4i16((LAS s16x4*)(img + a)); }
#define SCHEDB() __builtin_amdgcn_sched_barrier(0)

#define LDS_BARRIER() do { asm volatile("s_waitcnt lgkmcnt(0)" ::: "memory"); __builtin_amdgcn_s_barrier(); asm volatile("" ::: "memory"); } while (0)
DI void mix_gmlp_unit(const Frame& F0, int l, int b, int n) {
    Frame F = F0; F.ws = launder_s(F0.ws); F.in = launder_s(F0.in); { int t_ = F0.tid; asm volatile("" : "+v"(t_)); F.tid = t_; F.lane = t_ & 63; int c_ = __builtin_amdgcn_readfirstlane(F0.c); asm volatile("" : "+s"(c_)); F.c = c_; }
    const GAS bf16_t* proj = (const GAS bf16_t*)(F.ws + WS_PROJ); GAS bf16_t* mix = (GAS bf16_t*)(F.ws + WS_MIX);
    const GAS bf16_t* wst = (const GAS bf16_t*)(F.ws + WS_WST) + (size_t)l * 4 * 128 * 128;
    const GAS float* lng = F.in[I_LNG] + l * 512; const GAS float* lnb = F.in[I_LNB] + l * 512; const GAS float* bsp = F.in[I_BSP] + l * 512;
    const size_t grow0 = (size_t)b * SEQ + (size_t)n * CHUNK;
    int lane_ = F.lane; asm volatile("" : "+v"(lane_));
    const int lane = lane_, w = F.wave, fr = lane & 15, fq = lane >> 4;
    const MixLane ML = mix_lane(lane, w);
    LDS_BARRIER();
    {
        float g8[8], b8[8];
#pragma unroll
        for (int e = 0; e < 8; ++e) { g8[e] = lng[8 * lane + e]; b8[e] = lnb[8 * lane + e]; }
        LAS unsigned char* img = F.lds + (lane >> 4) * 32768;
        for (int i4 = 0; i4 < 16; i4 += 4) { u32x4 raw4[4];
#pragma unroll
            for (int k = 0; k < 4; ++k) raw4[k] = *(const GAS u32x4*)(proj + (grow0 + 16 * w + i4 + k) * INC + 512 + 8 * lane);
#pragma unroll
            for (int k = 0; k < 4; ++k) { const int row = 16 * w + i4 + k; const u32x4 raw = raw4[k];
            float x[8]; x[0] = bflo(raw.x); x[1] = bfhi(raw.x); x[2] = bflo(raw.y); x[3] = bfhi(raw.y); x[4] = bflo(raw.z); x[5] = bfhi(raw.z); x[6] = bflo(raw.w); x[7] = bfhi(raw.w);
            float s = 0.f;
#pragma unroll
            for (int e = 0; e < 8; ++e) { x[e] = gelu_tanh(x[e]); s += x[e]; }
            const float mean = wave_sum(s) * (1.0f / 512.0f); float s2 = 0.f;
#pragma unroll
            for (int e = 0; e < 8; ++e) { x[e] -= mean; s2 += x[e] * x[e]; }
            const float rstd = 1.0f / sqrtf(wave_sum(s2) * (1.0f / 512.0f) + EPS);
#pragma unroll
            for (int e = 0; e < 8; ++e) x[e] = x[e] * rstd * g8[e] + b8[e];
            u32x4 o; o.x = pk2(x[0], x[1]); o.y = pk2(x[2], x[3]); o.z = pk2(x[4], x[5]); o.w = pk2(x[6], x[7]);
            *(LAS u32x4*)(img + img_off(row, lane & 15)) = o; } }
    }
    LDS_BARRIER();
    const int t = 16 * w + fr;
    const int ncs = (16 * w + 15) / 32 + 1;
    for (int hd = 0; hd < 4; ++hd) {
        LAS unsigned char* img = F.lds + hd * 32768;
        bf16x8 wf[4];
#pragma unroll
        for (int c = 0; c < 4; ++c) wf[c] = *(const GAS bf16x8*)(wst + ((size_t)hd * 128 + t) * 128 + 32 * c + 8 * fq);
        const float bs = bsp[hd * 128 + t];
        f32x4 acc[8];
#pragma unroll
        for (int m = 0; m < 8; ++m) acc[m] = (f32x4){0.f, 0.f, 0.f, 0.f};
#pragma unroll
        for (int c = 0; c < 4; ++c) { if (c < ncs) {
#pragma unroll
            for (int m = 0; m < 8; ++m) { const bf16x8 a = cat8(trr(img, (ML.trA0 ^ (32u * m)) + 8192u * c), trr(img, (ML.trA1 ^ (32u * m)) + 8192u * c)); acc[m] = MFMA16(a, wf[c], acc[m]); } } }
        const GAS bf16_t* up = proj + (grow0 + t) * INC + 128 * hd + 4 * fq; GAS bf16_t* op = mix + (grow0 + t) * D + 128 * hd + 4 * fq;
        u32x2 uu8[8];
#pragma unroll
        for (int m = 0; m < 8; ++m) uu8[m] = *(const GAS u32x2*)(up + 16 * m);
#pragma unroll
        for (int m = 0; m < 8; ++m) { const u32x2 uu = uu8[m];
            const float o0 = gelu_tanh(bflo(uu.x)) * (acc[m][0] + bs), o1 = gelu_tanh(bfhi(uu.x)) * (acc[m][1] + bs), o2 = gelu_tanh(bflo(uu.y)) * (acc[m][2] + bs), o3 = gelu_tanh(bfhi(uu.y)) * (acc[m][3] + bs);
            u32x2 o; o.x = pk2(o0, o1); o.y = pk2(o2, o3); *(GAS u32x2*)(op + 16 * m) = o; }
    }
}

DI void mix_ret_unit(const Frame& F0, int l, int b, int h) {
    Frame F = F0; F.ws = launder_s(F0.ws); F.in = launder_s(F0.in); { int t_ = F0.tid; asm volatile("" : "+v"(t_)); F.tid = t_; F.lane = t_ & 63; int c_ = __builtin_amdgcn_readfirstlane(F0.c); asm volatile("" : "+s"(c_)); F.c = c_; }
    const GAS bf16_t* proj = (const GAS bf16_t*)(F.ws + WS_PROJ); GAS bf16_t* mix = (GAS bf16_t*)(F.ws + WS_MIX);
    const GAS float* rng = F.in[I_RNG] + l * 512 + h * 128;
    const int w = (F.wave < 4) ? 2 * F.wave : 15 - 2 * F.wave;
    LAS unsigned char* IS = F.lds + 0; LAS unsigned char* IK = F.lds + 32768; LAS unsigned char* IV = F.lds + 65536; LAS unsigned char* IQ = F.lds + 98304;
    const float lg2 = log2f(1.0f - exp2f(-5.0f - (float)h));
    const float g1 = exp2f(lg2), g127 = exp2f(127.0f * lg2), g128 = exp2f(128.0f * lg2);
    f32x4 st[8];
#pragma unroll
    for (int m = 0; m < 8; ++m) st[m] = (f32x4){0.f, 0.f, 0.f, 0.f};
    LDS_BARRIER();
    for (int u = F.tid; u < 32768 / 16; u += NTHR) *(LAS u32x4*)(IS + 16 * u) = (u32x4){0u, 0u, 0u, 0u};
    LAS float* RG = (LAS float*)(F.lds + L_GM);
    if (F.tid < 128) RG[F.tid] = rng[F.tid];
    u32x4 rq[2][2], rk[2][2], rv[2][2];
#define RET_LOAD(n_) do { int tid2 = F.tid; asm volatile("" : "+v"(tid2)); const int r0_ = tid2 >> 3, cc_ = tid2 & 7; \
        _Pragma("unroll") for (int i = 0; i < 2; ++i) { const GAS bf16_t* pr = proj + ((size_t)b * SEQ + (size_t)(n_) * CHUNK + r0_ + 64 * i) * INC + 128 * h + 8 * cc_; \
            rq[i][0] = *(const GAS u32x4*)(pr + 1024); rq[i][1] = *(const GAS u32x4*)(pr + 1024 + 64); rk[i][0] = *(const GAS u32x4*)(pr + 1536); rk[i][1] = *(const GAS u32x4*)(pr + 1536 + 64); \
            rv[i][0] = *(const GAS u32x4*)(pr + 2048); rv[i][1] = *(const GAS u32x4*)(pr + 2048 + 64); } } while (0)
    RET_LOAD(0);
    for (int n = 0; n < NCHUNK; ++n) {
        const size_t grow0 = (size_t)b * SEQ + (size_t)n * CHUNK;
        u32x2 gg[8];
        { int l0 = F.lane; asm volatile("" : "+v"(l0)); const GAS bf16_t* gp = proj + (grow0 + 16 * w + (l0 & 15)) * INC + 2560 + 128 * h + 4 * (l0 >> 4);
#pragma unroll
            for (int m = 0; m < 8; ++m) gg[m] = *(const GAS u32x2*)(gp + 16 * m); }
        {
            int tid2 = F.tid; asm volatile("" : "+v"(tid2));
            const int r0 = tid2 >> 3, cc = tid2 & 7;
            float itf[8];
#pragma unroll
            for (int e = 0; e < 8; ++e) itf[e] = __builtin_amdgcn_exp2f(-(float)(8 * cc + e) * (13.287712379549449f / 64.0f)) * 0.15915494309189535f;
#pragma unroll
            for (int i = 0; i < 2; ++i) { const int row = r0 + 64 * i; const float pos = (float)(n * CHUNK + row);
                float cs[8], sn[8];
#pragma unroll
                for (int e = 0; e < 8; ++e) { const float tt = pos * itf[e]; const float fr = __builtin_amdgcn_fractf(tt); cs[e] = __builtin_amdgcn_cosf(fr); sn[e] = __builtin_amdgcn_sinf(fr); }
#pragma unroll
                for (int which = 0; which < 2; ++which) {
                    const u32x4 lo = which ? rk[i][0] : rq[i][0], hi = which ? rk[i][1] : rq[i][1];
                    const unsigned lw[4] = {lo.x, lo.y, lo.z, lo.w}, hw[4] = {hi.x, hi.y, hi.z, hi.w};
                    float a[8], bb[8];
#pragma unroll
                    for (int e = 0; e < 4; ++e) { a[2 * e] = bflo(lw[e]); a[2 * e + 1] = bfhi(lw[e]); bb[2 * e] = bflo(hw[e]); bb[2 * e + 1] = bfhi(hw[e]); }
                    const float sc = which ? 0.08838834764831845f : 1.0f;
                    float ra[8], rb[8];
#pragma unroll
                    for (int e = 0; e < 8; ++e) { ra[e] = (a[e] * cs[e] - bb[e] * sn[e]) * sc; rb[e] = (a[e] * sn[e] + bb[e] * cs[e]) * sc; }
                    LAS unsigned char* img = which ? IK : IQ;
                    u32x4 o; o.x = pk2(ra[0], ra[1]); o.y = pk2(ra[2], ra[3]); o.z = pk2(ra[4], ra[5]); o.w = pk2(ra[6], ra[7]);
                    *(LAS u32x4*)(img + img_off(row, cc)) = o;
                    o.x = pk2(rb[0], rb[1]); o.y = pk2(rb[2], rb[3]); o.z = pk2(rb[4], rb[5]); o.w = pk2(rb[6], rb[7]);
                    *(LAS u32x4*)(img + img_off(row, cc + 8)) = o; }
                const float vs = __builtin_amdgcn_exp2f(-(float)row * lg2);
#pragma unroll
                for (int half = 0; half < 2; ++half) { const u32x4 vv = rv[i][half];
                    u32x4 o; o.x = pk2(bflo(vv.x) * vs, bfhi(vv.x) * vs); o.y = pk2(bflo(vv.y) * vs, bfhi(vv.y) * vs); o.z = pk2(bflo(vv.z) * vs, bfhi(vv.z) * vs); o.w = pk2(bflo(vv.w) * vs, bfhi(vv.w) * vs);
                    *(LAS u32x4*)(IV + img_off(row, cc + 8 * half)) = o; } }
        }
        if (n + 1 < NCHUNK) RET_LOAD(n + 1);
        LDS_BARRIER();
        int lane_ = F.lane; asm volatile("" : "+v"(lane_));
        const int lane = lane_, fr = lane & 15, fq = lane >> 4, t = 16 * w + fr;
        const MixLane ML = mix_lane(lane, w);
        const float gt = __builtin_amdgcn_exp2f((float)t * lg2);
        bf16x8 qf[4];
#pragma unroll
        for (int c = 0; c < 4; ++c) qf[c] = *(const LAS bf16x8*)(IQ + ((ML.rbase ^ (64u * c)) + 4096u * (unsigned)w));
        f32x4 accS[8];
#pragma unroll
        for (int a = 0; a < 8; ++a) { accS[a] = (f32x4){0.f, 0.f, 0.f, 0.f};
            if (a <= w) {
#pragma unroll
                for (int c = 0; c < 4; ++c) { const bf16x8 kf = *(const LAS bf16x8*)(IK + ((ML.rbase ^ (64u * c)) + 4096u * a)); accS[a] = MFMA16(kf, qf[c], accS[a]); }
                if (a == w) {
#pragma unroll
                    for (int j = 0; j < 4; ++j) if (4 * fq + j > fr) accS[a][j] = 0.f; } } }
        SCHEDB();
        f32x4 accO[8];
#pragma unroll
        for (int m = 0; m < 8; ++m) accO[m] = (f32x4){0.f, 0.f, 0.f, 0.f};
#pragma unroll
        for (int c = 0; c < 4; ++c) { if (2 * c <= w) {
            u32x4 pw; pw.x = pk2(accS[2 * c][0], accS[2 * c][1]); pw.y = pk2(accS[2 * c][2], accS[2 * c][3]); pw.z = pk2(accS[2 * c + 1][0], accS[2 * c + 1][1]); pw.w = pk2(accS[2 * c + 1][2], accS[2 * c + 1][3]);
            const bf16x8 pf = __builtin_bit_cast(bf16x8, pw);
#pragma unroll
            for (int m = 0; m < 8; ++m) { const bf16x8 vf = cat8(trr(IV, (ML.trB ^ (32u * m)) + 8192u * c), trr(IV, (ML.trB ^ (32u * m)) + 8192u * c + 4096u)); accO[m] = MFMA16(vf, pf, accO[m]); }
            SCHEDB(); } }
#pragma unroll
        for (int c = 0; c < 4; ++c) {
#pragma unroll
            for (int m = 0; m < 8; ++m) { const bf16x8 sf = cat8(trr(IS, (ML.trA0 ^ (32u * m)) + 8192u * c), trr(IS, (ML.trA1 ^ (32u * m)) + 8192u * c)); accO[m] = MFMA16(sf, qf[c], accO[m]); }
            SCHEDB(); }
        {
            float ss = 0.f;
#pragma unroll
            for (int m = 0; m < 8; ++m) { accO[m] = accO[m] * gt; ss += (accO[m][0] * accO[m][0] + accO[m][1] * accO[m][1]) + (accO[m][2] * accO[m][2] + accO[m][3] * accO[m][3]); }
            ss += __shfl_xor(ss, 16); ss += __shfl_xor(ss, 32);
            const float rstd = 1.0f / sqrtf(ss * (1.0f / 128.0f) + EPS);
            GAS bf16_t* op = mix + (grow0 + t) * D + 512 + 128 * h + 4 * fq;
#pragma unroll
            for (int m = 0; m < 8; ++m) { const f32x4 rg = *(const LAS f32x4*)(RG + 16 * m + 4 * fq);
                const float o0 = accO[m][0] * rstd * rg[0] * bflo(gg[m].x), o1 = accO[m][1] * rstd * rg[1] * bfhi(gg[m].x), o2 = accO[m][2] * rstd * rg[2] * bflo(gg[m].y), o3 = accO[m][3] * rstd * rg[3] * bfhi(gg[m].y);
                u32x2 o; o.x = pk2(o0, o1); o.y = pk2(o2, o3); *(GAS u32x2*)(op + 16 * m) = o; }
        }
        SCHEDB();
        {
            bf16x8 kt[4];
#pragma unroll
            for (int c = 0; c < 4; ++c) kt[c] = cat8(trr(IK, (ML.trA0 ^ (32u * (unsigned)w)) + 8192u * c), trr(IK, (ML.trA1 ^ (32u * (unsigned)w)) + 8192u * c));
#pragma unroll
            for (int m = 0; m < 8; ++m) { f32x4 kv = (f32x4){0.f, 0.f, 0.f, 0.f};
#pragma unroll
                for (int c = 0; c < 4; ++c) { const bf16x8 vf = cat8(trr(IV, (ML.trA0 ^ (32u * m)) + 8192u * c), trr(IV, (ML.trA1 ^ (32u * m)) + 8192u * c)); kv = MFMA16(vf, kt[c], kv); }
                st[m] = st[m] * g128 + kv * g127; SCHEDB(); }
        }
        LDS_BARRIER();
#pragma unroll
        for (int m = 0; m < 8; ++m) { u32x2 o; o.x = pk2(st[m][0] * g1, st[m][1] * g1); o.y = pk2(st[m][2] * g1, st[m][3] * g1);
            *(LAS u32x2*)(IS + (ML.wbase ^ (32u * m))) = o; }
    }
#undef RET_LOAD
    LDS_BARRIER();
}

DI void mix_phase(const Frame& F0, int l) {
    Frame F = F0; { int c_ = __builtin_amdgcn_readfirstlane(F0.c); asm volatile("" : "+s"(c_)); F.c = c_; }
    const int NR = BATCH * 4, NGM = BATCH * NCHUNK;
    if (F.G >= 2 * NR) {
        if (F.c < NR) mix_ret_unit(F, l, F.c >> 2, F.c & 3);
        else for (int it = F.c - NR; it < NGM; it += F.G - NR) mix_gmlp_unit(F, l, it / NCHUNK, it % NCHUNK);
    } else {
        for (int it = F.c; it < NR; it += F.G) mix_ret_unit(F, l, it >> 2, it & 3);
        for (int it = F.c; it < NGM; it += F.G) mix_gmlp_unit(F, l, it / NCHUNK, it % NCHUNK);
    }
    __syncthreads();
}

DI void n2_phase(const Frame& F0, int l) {
    Frame F = F0; F.ws = launder_s(F0.ws); F.in = launder_s(F0.in); { int t_ = F0.tid; asm volatile("" : "+v"(t_)); F.tid = t_; F.lane = t_ & 63; int c_ = __builtin_amdgcn_readfirstlane(F0.c); asm volatile("" : "+s"(c_)); F.c = c_; }
    const GAS bf16_t* x1 = (const GAS bf16_t*)(F.ws + WS_XA);
    const GAS float* br = F.in[I_BR] + l * NE;
    const GAS float* mod = (const GAS float*)(F.ws + WS_MOD) + (size_t)l * BATCH * (NMOD * D);
    GAS unsigned char* H8 = (GAS unsigned char*)(F.ws + WS_H);
    GAS int* tokinfo = (GAS int*)(F.ws + WS_TOKINFO); GAS float* tokw = (GAS float*)(F.ws + WS_TOKW); GAS int* slot_tok = (GAS int*)(F.ws + WS_SLOTTOK);
    GAS unsigned* gcnt = (GAS unsigned*)(F.ws + WS_CTL) + CW_CNT + l * 64;
    LAS int* lcnt = (LAS int*)(F.lds + L_LCNT); LAS int* lbase = (LAS int*)(F.lds + L_BASE);
    LAS int* tinfo = (LAS int*)(F.lds + L_TINFO); LAS float* tw = (LAS float*)(F.lds + L_TW);
    LAS float* GM = (LAS float*)(F.lds + L_GM); LAS float* SV = (LAS float*)(F.lds + L_SV);
    const int lane = F.lane, ri = lane & 15, g = lane >> 4;
    __syncthreads();
    {
        const GAS u32x4* src = (const GAS u32x4*)(F.ws + WS_WRT + (size_t)l * WRI_BYTES);
        for (int u0 = F.tid; u0 < WRI_BYTES / 16; u0 += 6 * NTHR) { u32x4 t6[6];
#pragma unroll
            for (int k = 0; k < 6; ++k) { const int u = u0 + k * NTHR; t6[k] = src[u < WRI_BYTES / 16 ? u : u0]; }
#pragma unroll
            for (int k = 0; k < 6; ++k) { const int u = u0 + k * NTHR; if (u < WRI_BYTES / 16) ((LAS u32x4*)F.lds)[u] = t6[k]; } }
    }
    const float brl0 = br[ri], brl1 = br[16 + ri];
    for (int blk = F.c; blk < T / 256; blk += F.G) {
        const int tok0 = blk * 256, b = tok0 / SEQ; const GAS float* mb = mod + (size_t)b * (NMOD * D);
        __syncthreads();
        if (F.tid < 32) lcnt[F.tid] = 0;
        for (int i = F.tid; i < D; i += NTHR) { GM[i] = F.in[I_GFFN][l * D + i] * (1.0f + mb[4 * D + i]); SV[i] = mb[3 * D + i]; }
        __syncthreads();
#pragma unroll 1
        for (int mt = 0; mt < 2; ++mt) {
            const int tl = F.wave * 32 + mt * 16 + ri;
            const GAS bf16_t* xrow = x1 + (size_t)(tok0 + tl) * D + 8 * g;
            float ss = 0.f;
            { u32x4 v[32];
#pragma unroll
                for (int k = 0; k < 32; ++k) v[k] = *(const GAS u32x4*)(xrow + 32 * k);
#pragma unroll
                for (int k = 0; k < 32; ++k) { const float a0 = bflo(v[k].x), a1 = bfhi(v[k].x), a2 = bflo(v[k].y), a3 = bfhi(v[k].y), a4 = bflo(v[k].z), a5 = bfhi(v[k].z), a6 = bflo(v[k].w), a7 = bfhi(v[k].w);
                    ss += ((a0 * a0 + a1 * a1) + (a2 * a2 + a3 * a3)) + ((a4 * a4 + a5 * a5) + (a6 * a6 + a7 * a7)); } }
            ss += __shfl_xor(ss, 16); ss += __shfl_xor(ss, 32);
            const float rstd = 1.0f / sqrtf(ss * (1.f / D) + EPS);
            f32x4 acc0 = (f32x4){0.f, 0.f, 0.f, 0.f}, acc1 = acc0;
            GAS unsigned char* hrow = H8 + (size_t)(tok0 + tl) * D + 8 * g;
            u32x4 ra[8], rb[8];
#pragma unroll
            for (int k = 0; k < 8; ++k) ra[k] = *(const GAS u32x4*)(xrow + 32 * k);
#pragma unroll 1
            for (int kb = 0; kb < 4; ++kb) {
            const int kn = kb < 3 ? kb + 1 : kb;
#pragma unroll
            for (int k = 0; k < 8; ++k) rb[k] = *(const GAS u32x4*)(xrow + 32 * (8 * kn + k));
            SCHEDB();
#pragma unroll
            for (int k = 0; k < 8; ++k) { const int kk = 8 * kb + k;
                const u32x4 raw = ra[k];
                const f32x4 g0 = *(const LAS f32x4*)(GM + 32 * kk + 8 * g), g1 = *(const LAS f32x4*)(GM + 32 * kk + 8 * g + 4), s0 = *(const LAS f32x4*)(SV + 32 * kk + 8 * g), s1 = *(const LAS f32x4*)(SV + 32 * kk + 8 * g + 4);
                float h[8]; h[0] = bflo(raw.x) * rstd * g0[0] + s0[0]; h[1] = bfhi(raw.x) * rstd * g0[1] + s0[1]; h[2] = bflo(raw.y) * rstd * g0[2] + s0[2]; h[3] = bfhi(raw.y) * rstd * g0[3] + s0[3];
                h[4] = bflo(raw.z) * rstd * g1[0] + s1[0]; h[5] = bfhi(raw.z) * rstd * g1[1] + s1[1]; h[6] = bflo(raw.w) * rstd * g1[2] + s1[2]; h[7] = bfhi(raw.w) * rstd * g1[3] + s1[3];
                u32x2 f8; f8.x = pk4_fp8(clamp8(h[0]), clamp8(h[1]), clamp8(h[2]), clamp8(h[3])); f8.y = pk4_fp8(clamp8(h[4]), clamp8(h[5]), clamp8(h[6]), clamp8(h[7]));
                *(GAS u32x2*)(hrow + 32 * kk) = f8;
                u32x4 hi, lo; hi.x = pk2(h[0], h[1]); hi.y = pk2(h[2], h[3]); hi.z = pk2(h[4], h[5]); hi.w = pk2(h[6], h[7]);
                lo.x = pk2(h[0] - bflo(hi.x), h[1] - bfhi(hi.x)); lo.y = pk2(h[2] - bflo(hi.y), h[3] - bfhi(hi.y)); lo.z = pk2(h[4] - bflo(hi.z), h[5] - bfhi(hi.z)); lo.w = pk2(h[6] - bflo(hi.w), h[7] - bfhi(hi.w));
                const bf16x8 ahi = __builtin_bit_cast(bf16x8, hi), alo = __builtin_bit_cast(bf16x8, lo);
                const LAS unsigned char* wp = F.lds + ri * WRI_ROWB + (32 * kk + 8 * g) * 2;
                const bf16x8 wh0 = *(const LAS bf16x8*)(wp), wh1 = *(const LAS bf16x8*)(wp + 16 * WRI_ROWB), wl0 = *(const LAS bf16x8*)(wp + 32 * WRI_ROWB), wl1 = *(const LAS bf16x8*)(wp + 48 * WRI_ROWB);
                acc0 = MFMA16(ahi, wh0, acc0); acc0 = MFMA16(alo, wh0, acc0); acc0 = MFMA16(ahi, wl0, acc0);
                acc1 = MFMA16(ahi, wh1, acc1); acc1 = MFMA16(alo, wh1, acc1); acc1 = MFMA16(ahi, wl1, acc1);
            }
#pragma unroll
            for (int k = 0; k < 8; ++k) ra[k] = rb[k];
            }
#pragma unroll
            for (int jj = 0; jj < 4; ++jj) {
                float v0 = acc0[jj] + brl0, v1 = acc1[jj] + brl1; int se[4]; float sv4[4];
#pragma unroll
                for (int k = 0; k < 4; ++k) {
                    float bv = v0 >= v1 ? v0 : v1; int bi = v0 >= v1 ? ri : 16 + ri;
#pragma unroll
                    for (int o = 1; o < 16; o <<= 1) { const float ov = __shfl_xor(bv, o); const int oi = __shfl_xor(bi, o); const bool take = (ov > bv) || (ov == bv && oi < bi); bv = take ? ov : bv; bi = take ? oi : bi; }
                    se[k] = bi; sv4[k] = bv; v0 = (bi == ri) ? -3.0e38f : v0; v1 = (bi == 16 + ri) ? -3.0e38f : v1; }
                if (ri == 0) {
                    float ex[4], sum = 0.f;
#pragma unroll
                    for (int k = 0; k < 4; ++k) { ex[k] = __expf(sv4[k] - sv4[0]); sum += ex[k]; }
                    const float inv = 1.0f / sum; const int tt = F.wave * 32 + mt * 16 + 4 * g + jj;
#pragma unroll
                    for (int k = 0; k < 4; ++k) { const int rank = __hip_atomic_fetch_add(lcnt + se[k], 1, __ATOMIC_RELAXED, __HIP_MEMORY_SCOPE_WORKGROUP);
                        tinfo[tt * 4 + k] = (se[k] << 17) | rank; tw[tt * 4 + k] = ex[k] * inv; } }
            }
        }
        __syncthreads();
        if (F.tid < 32) lbase[F.tid] = (int)__hip_atomic_fetch_add(gcnt + F.tid, (unsigned)lcnt[F.tid], __ATOMIC_RELAXED, __HIP_MEMORY_SCOPE_AGENT);
        __syncthreads();
        if (F.tid < 256) { const int tok = tok0 + F.tid;
#pragma unroll
            for (int k = 0; k < 4; ++k) { const int ti = tinfo[F.tid * 4 + k]; const int e = ti >> 17, pos = lbase[e] + (ti & 0x1ffff);
                slot_tok[(size_t)e * ECAP + pos] = tok; tokinfo[tok * 4 + k] = (e << 17) | pos; tokw[tok * 4 + k] = tw[F.tid * 4 + k]; } }
    }
    __syncthreads();
}

DI void moe_tables(const Frame& F0, int l) {
    Frame F = F0; F.ws = launder_s(F0.ws); F.in = launder_s(F0.in); { int t_ = F0.tid; asm volatile("" : "+v"(t_)); F.tid = t_; F.lane = t_ & 63; int c_ = __builtin_amdgcn_readfirstlane(F0.c); asm volatile("" : "+s"(c_)); F.c = c_; }
    const GAS unsigned* gcnt = (const GAS unsigned*)(F.ws + WS_CTL) + CW_CNT + l * 64;
    LAS int* cnt = (LAS int*)(F.lds + L_CNT); LAS int* tpre = (LAS int*)(F.lds + L_TPRE); LAS unsigned char* rt2e = F.lds + L_RT2E;
    __syncthreads();
    if (F.tid < 32) cnt[F.tid] = (int)__hip_atomic_load(gcnt + F.tid, __ATOMIC_RELAXED, __HIP_MEMORY_SCOPE_AGENT);
    __syncthreads();
    if (F.tid == 0) { int s = 0; for (int e = 0; e < 32; ++e) { tpre[e] = s; s += (cnt[e] + 255) >> 8; } tpre[32] = s; }
    __syncthreads();
    const int nrt = tpre[32];
    for (int rt = F.tid; rt < nrt; rt += NTHR) { int e = 0; for (int k = 1; k < 32; ++k) e += (tpre[k] <= rt) ? 1 : 0; rt2e[rt] = (unsigned char)e; }
    __syncthreads();
}

DI void combine_phase(const Frame& F0, int l) {
    Frame F = F0; F.ws = launder_s(F0.ws); F.in = launder_s(F0.in); { int t_ = F0.tid; asm volatile("" : "+v"(t_)); F.tid = t_; F.lane = t_ & 63; int c_ = __builtin_amdgcn_readfirstlane(F0.c); asm volatile("" : "+s"(c_)); F.c = c_; }
    const GAS bf16_t* x1 = (const GAS bf16_t*)(F.ws + WS_XA); GAS bf16_t* x2 = (GAS bf16_t*)(F.ws + WS_XB);
    const GAS unsigned char* Y = (const GAS unsigned char*)(F.ws + WS_Y);
    const GAS int* tokinfo = (const GAS int*)(F.ws + WS_TOKINFO); const GAS float* tokw = (const GAS float*)(F.ws + WS_TOKW);
    const GAS float* mod = (const GAS float*)(F.ws + WS_MOD);
    LAS int* tpre = (LAS int*)(F.lds + L_TPRE);
    const int gw = F.c * NWAVES + F.wave, NGW = F.G * NWAVES, lane = F.lane;
    const bool lastl = (l == DEPTH - 1);
    for (int blk = gw; blk < T / 32; blk += NGW) {
        const int row0 = blk * 32, b = row0 / SEQ;
        const GAS float* mb = mod + ((size_t)l * BATCH + b) * (NMOD * D);
        const GAS float* mn = mod + ((size_t)(lastl ? l : l + 1) * BATCH + b) * (NMOD * D);
        f32x4 gf[2][2], gm[2][2], sv[2][2];
#pragma unroll
        for (int j = 0; j < 2; ++j)
#pragma unroll
            for (int q = 0; q < 2; ++q) { const int col = 512 * j + 8 * lane + 4 * q; gf[j][q] = *(const GAS f32x4*)(mb + 5 * D + col);
                if (lastl) { gm[j][q] = *(const GAS f32x4*)(F.in[I_GFIN] + col); sv[j][q] = (f32x4){0.f, 0.f, 0.f, 0.f}; }
                else { const f32x4 gg = *(const GAS f32x4*)(F.in[I_GMIX] + (l + 1) * D + col), ss = *(const GAS f32x4*)(mn + 1 * D + col); gm[j][q] = gg * (ss + 1.0f); sv[j][q] = *(const GAS f32x4*)(mn + 0 * D + col); } }
        int sl[4]; float wk4[4];
        { const int rr = lane & 31; const u32x4 ti = *(const GAS u32x4*)(tokinfo + (size_t)(row0 + rr) * 4); const f32x4 tw = *(const GAS f32x4*)(tokw + (size_t)(row0 + rr) * 4);
            const unsigned tiw[4] = {ti.x, ti.y, ti.z, ti.w};
#pragma unroll
            for (int k = 0; k < 4; ++k) { const int e = (int)(tiw[k] >> 17), pos = (int)(tiw[k] & 0x1ffffu); sl[k] = tpre[e] * 256 + pos; wk4[k] = tw[k]; } }
        for (int r = 0; r < 32; r += 2) {
            u32x2 yy[2][4][2]; u32x4 xv[2][2]; float wk[2][4];
#pragma unroll
            for (int u = 0; u < 2; ++u) {
#pragma unroll
                for (int k = 0; k < 4; ++k) { const int slot = __builtin_amdgcn_readlane(sl[k], r + u); wk[u][k] = __builtin_bit_cast(float, __builtin_amdgcn_readlane(__builtin_bit_cast(int, wk4[k]), r + u));
                    const GAS u32x2* yr = (const GAS u32x2*)(Y + (size_t)slot * D) + lane;
#pragma unroll
                    for (int j = 0; j < 2; ++j) yy[u][k][j] = __builtin_nontemporal_load(yr + 64 * j); }
                const GAS u32x4* xr = (const GAS u32x4*)(x1 + (size_t)(row0 + r + u) * D) + lane;
#pragma unroll
                for (int j = 0; j < 2; ++j) xv[u][j] = __builtin_nontemporal_load(xr + 64 * j); }
#pragma unroll
            for (int u = 0; u < 2; ++u) {
                const int tok = row0 + r + u;
                f32x4 v[2][2]; float s = 0.f;
#pragma unroll
                for (int j = 0; j < 2; ++j) { f32x4 m0 = (f32x4){0.f, 0.f, 0.f, 0.f}, m1 = m0;
#pragma unroll
                    for (int k = 0; k < 4; ++k) { m0 += unpk4_fp8(yy[u][k][j].x) * wk[u][k]; m1 += unpk4_fp8(yy[u][k][j].y) * wk[u][k]; }
                    const u32x4 xw = xv[u][j];
                    v[j][0] = (f32x4){bflo(xw.x), bfhi(xw.x), bflo(xw.y), bfhi(xw.y)} + gf[j][0] * m0; v[j][1] = (f32x4){bflo(xw.z), bfhi(xw.z), bflo(xw.w), bfhi(xw.w)} + gf[j][1] * m1;
#pragma unroll
                    for (int q = 0; q < 2; ++q) s += (v[j][q].x * v[j][q].x + v[j][q].y * v[j][q].y) + (v[j][q].z * v[j][q].z + v[j][q].w * v[j][q].w); }
                const float rstd = 1.0f / sqrtf(wave_sum(s) * (1.f / D) + EPS);
                if (lastl) { GAS f32x4* o = (GAS f32x4*)(F.out + (size_t)tok * D + 8 * lane);
#pragma unroll
                    for (int j = 0; j < 2; ++j) { o[128 * j] = v[j][0] * rstd * gm[j][0]; o[128 * j + 1] = v[j][1] * rstd * gm[j][1]; } }
                else { GAS u32x4* xo = (GAS u32x4*)(x2 + (size_t)tok * D) + lane; GAS u32x4* ho = (GAS u32x4*)((GAS bf16_t*)(F.ws + WS_H) + (size_t)tok * D) + lane;
#pragma unroll
                    for (int j = 0; j < 2; ++j) { u32x4 xw; xw.x = pk2(v[j][0].x, v[j][0].y); xw.y = pk2(v[j][0].z, v[j][0].w); xw.z = pk2(v[j][1].x, v[j][1].y); xw.w = pk2(v[j][1].z, v[j][1].w); xo[64 * j] = xw;
                        const f32x4 h0 = v[j][0] * rstd * gm[j][0] + sv[j][0], h1 = v[j][1] * rstd * gm[j][1] + sv[j][1];
                        if (l + 1 >= G1_FP8_FROM) { u32x2 h8; h8.x = pk4_fp8(clamp8(h0.x), clamp8(h0.y), clamp8(h0.z), clamp8(h0.w)); h8.y = pk4_fp8(clamp8(h1.x), clamp8(h1.y), clamp8(h1.z), clamp8(h1.w));
                            ((GAS u32x2*)((GAS unsigned char*)(F.ws + WS_H) + (size_t)tok * D) + lane)[64 * j] = h8; }
                        else { u32x4 hw; hw.x = pk2(h0.x, h0.y); hw.y = pk2(h0.z, h0.w); hw.z = pk2(h1.x, h1.y); hw.w = pk2(h1.z, h1.w); ho[64 * j] = hw; } } }
            }
        }
    }
}

constexpr int N_PHASES = 2 + 7 * DEPTH;
__global__ void __launch_bounds__(NTHR, 2) fwd_kernel(Args args) {
    extern __shared__ __attribute__((aligned(16))) unsigned char lds_raw[];
    Frame F;
    F.lds = (LAS unsigned char*)lds_raw; F.ws = (GAS unsigned char*)args.ws; F.out = (GAS float*)args.out;
    F.in = (const GAS float* const CAS*)__builtin_amdgcn_kernarg_segment_ptr();
    F.tid = threadIdx.x; F.lane = F.tid & 63; F.wave = __builtin_amdgcn_readfirstlane(F.tid >> 6);
    F.G = gridDim.x; F.c = blockIdx.x;
    const int lo = args.ph_lo, hi = args.ph_hi;
    if (F.tid < 4) ((LAS unsigned*)(F.lds + L_MISC))[F.tid] = 0u;
    __syncthreads();
    XcdBarrier bar; bar.bar = (GAS unsigned*)(F.ws + WS_CTL) + CW_BAR; bar.x = 0; bar.st = (volatile LAS unsigned*)(F.lds + L_MISC);
    if (hi - lo > 1) bar = xcd_barrier_post((GAS unsigned*)(F.ws + WS_CTL) + CW_BAR, (volatile LAS unsigned*)(F.lds + L_MISC));
#define IN(k) (lo <= (k) && (k) < hi)
#define SEAM(k) do { if (IN(k) && IN((k) + 1)) xcd_barrier(bar); } while (0)
#ifndef DUP_PHASE
#define DUP_PHASE -1
#endif
#define REPS(k) for (int rep_ = 0; rep_ < ((DUP_PHASE) == (k) ? 2 : 1); ++rep_)
#define REPBAR() do { if (rep_ == 0 && (DUP_PHASE) >= 0) xcd_barrier(bar); } while (0)

    if (IN(0)) { p0_mod(F); p0_tables(F); }
    SEAM(0);
    if (IN(1)) REPS(8) { p1_prologue(F); if ((DUP_PHASE) == 8) REPBAR(); }
    SEAM(1);
    for (int l = 0; l < DEPTH; ++l) {
        const int pb = 2 + 7 * l;
        if (IN(pb + 0)) REPS(0) {
            GAS unsigned char* ws = launder_s(F.ws);
            EpiProj E{(GAS bf16_t*)(ws + WS_PROJ)};
            if (l >= G1_FP8_FROM) { DenseSched8 S; S.init(ws + WS_H, ws + WS_WIN + (size_t)l * INC * D * 2, T, INC, F.G, F.c); gemm_phase(F.lds, S, E); }
            else { DenseSched S; S.init(ws + WS_H, ws + WS_WIN + (size_t)l * INC * D * 2, T, INC, F.G, F.c); gemm_phase(F.lds, S, E); }
            if ((DUP_PHASE) == 0) REPBAR();
        }
        SEAM(pb + 0);
        if (IN(pb + 1)) REPS(1) { mix_phase(F, l); if ((DUP_PHASE) == 1) REPBAR(); }
        SEAM(pb + 1);
        if (IN(pb + 2)) REPS(2) {
            GAS unsigned char* ws = launder_s(F.ws); const GAS float* const CAS* in = launder_s(F.in);
            const GAS float* xin32 = (l == 0) ? in[I_X] : nullptr;
            DenseSched S; S.init(ws + WS_MIX, ws + WS_WOUT + (size_t)l * D * D * 2, T, D, F.G, F.c);
            EpiResid E{xin32, (const GAS bf16_t*)(ws + WS_XB), (GAS bf16_t*)(ws + WS_XA), (const GAS float*)(ws + WS_MOD) + (size_t)l * BATCH * (NMOD * D) + 2 * D};
            gemm_phase(F.lds, S, E);
            if ((DUP_PHASE) == 2) REPBAR();
        }
        SEAM(pb + 2);
        if (IN(pb + 3)) REPS(3) { n2_phase(F, l); if ((DUP_PHASE) == 3 && rep_ == 0) { xcd_barrier(bar); if (F.c == 0 && F.tid < 32) ((GAS unsigned*)(F.ws + WS_CTL))[CW_CNT + l * 64 + F.tid] = 0u; xcd_barrier(bar); } }
        SEAM(pb + 3);
        if (IN(pb + 4)) REPS(4) {
            moe_tables(F, l);
            GAS unsigned char* ws = launder_s(F.ws); const GAS float* const CAS* in = launder_s(F.in);
            MoeSched<true, 8, 2 * FF> S; S.init(ws + WS_H, ws + WS_W1 + (size_t)l * NE * 2 * FF * D, (const GAS int*)(ws + WS_SLOTTOK), F.lds, F.G, F.c);
            EpiSwiglu E{(GAS unsigned char*)(ws + WS_ACT), in[I_B1] + (size_t)l * NE * 2 * FF};
            gemm_phase(F.lds, S, E);
            if ((DUP_PHASE) == 4) REPBAR();
        }
        SEAM(pb + 4);
        if (IN(pb + 5)) REPS(5) {
            if (!IN(pb + 4)) moe_tables(F, l);
            GAS unsigned char* ws = launder_s(F.ws); const GAS float* const CAS* in = launder_s(F.in);
            MoeSched<false, 4, D> S; S.init(ws + WS_ACT, ws + WS_W2 + (size_t)l * NE * D * FF, (const GAS int*)(ws + WS_SLOTTOK), F.lds, F.G, F.c);
            EpiY E{(GAS unsigned char*)(ws + WS_Y), in[I_B2] + (size_t)l * NE * D};
            gemm_phase(F.lds, S, E);
            if ((DUP_PHASE) == 5) REPBAR();
        }
        SEAM(pb + 5);
        if (IN(pb + 6)) REPS(6) { if (!IN(pb + 4)) moe_tables(F, l); combine_phase(F, l); if ((DUP_PHASE) == 6) REPBAR(); }
        SEAM(pb + 6);
    }
#undef IN
#undef SEAM
}
}

extern "C" void kernel_launch(void* const* d_in, const int* in_sizes, int n_in, void* d_out, int out_size, void* d_ws, size_t ws_size, hipStream_t stream) {
    static int grid = 0;
    if (grid == 0) {
        if (n_in != 20 || in_sizes[0] != T * D || out_size != T * D || ws_size < WS_END) { fprintf(stderr, "kernel_launch: unexpected shapes (n_in %d, in0 %d, out %d, ws %zu < %zu)\n", n_in, n_in > 0 ? in_sizes[0] : -1, out_size, ws_size, (size_t)WS_END); grid = -1; return; }
        int dev = 0, cus = 0, per_cu = 0;
        if (hipGetDevice(&dev) != hipSuccess || hipDeviceGetAttribute(&cus, hipDeviceAttributeMultiprocessorCount, dev) != hipSuccess) { grid = -1; return; }
        if (hipFuncSetAttribute((const void*)fwd_kernel, hipFuncAttributeMaxDynamicSharedMemorySize, LDS_BYTES) != hipSuccess) { fprintf(stderr, "kernel_launch: hipFuncSetAttribute failed\n"); grid = -1; return; }
        if (hipOccupancyMaxActiveBlocksPerMultiprocessor(&per_cu, (const void*)fwd_kernel, NTHR, LDS_BYTES) != hipSuccess || per_cu < 1) { fprintf(stderr, "kernel_launch: occupancy query says %d\n", per_cu); }
        (void)hipGetLastError();
        grid = cus;
    }
    if (grid < 0) return;
    (void)hipMemsetAsync((char*)d_ws + WS_CTL, 0, CTL_BYTES, stream);
    Args a{};
    for (int i = 0; i < 20; ++i) a.in[i] = (const float*)d_in[i];
    a.out = (float*)d_out; a.ws = (unsigned char*)d_ws;
#if MK_LAUNCH_PER_PHASE
    for (int p = 0; p < N_PHASES; ++p) { a.ph_lo = p; a.ph_hi = p + 1; hipLaunchKernelGGL(fwd_kernel, dim3(grid), dim3(NTHR), LDS_BYTES, stream, a); }
#else
    a.ph_lo = 0; a.ph_hi = N_PHASES;
    hipLaunchKernelGGL(fwd_kernel, dim3(grid), dim3(NTHR), LDS_BYTES, stream, a);
#endif
}
```
